# Optimizing an MI355X kernel written in HIP

```python
import jax, jax.numpy as jnp
from jax import lax
import numpy as np

D_MODEL = 1024
BATCH = 8
SEQ = 4096
DEPTH = 2

CTX_LEN = 256
GRID_W = 64
HEAD_DIM = 64
D_FF = ((8 * D_MODEL // 3 + 127) // 128) * 128
D_LRU = D_MODEL // 2
N_LRU_HEADS = D_LRU // HEAD_DIM
D_GMLP = D_MODEL // 4
N_GMLP_GROUPS = D_GMLP // HEAD_DIM
GMLP_CHUNK = 128
D_FNET = D_MODEL // 4
N_FNET_GROUPS = D_FNET // HEAD_DIM
D_MIX = D_LRU + D_GMLP + D_FNET
D_IN = 2 * D_LRU + 2 * D_GMLP + D_FNET
CONV_W = 4
LRU_C = 8.0
N_MOD = 9
EPS = 1e-6

kernel_name = "hybrid_rglru_gmlp_fnet_macaron_dit"


def rmsnorm(x, g):
    xf = x.astype(jnp.float32)
    y = xf * lax.rsqrt(jnp.mean(xf * xf, axis=-1, keepdims=True) + EPS)
    return (y * g.astype(jnp.float32)).astype(x.dtype)


def adaln(c_vec, w, b):
    m = jax.nn.silu(c_vec) @ w + b
    return m.reshape(m.shape[:-1] + (1, N_MOD, D_MODEL))


def sincos_2d(rows, d):
    r, col = jnp.meshgrid(jnp.arange(rows, dtype=jnp.float32),
                          jnp.arange(GRID_W, dtype=jnp.float32), indexing="ij")
    q = d // 4
    freqs = 1.0 / (10000.0 ** (jnp.arange(q, dtype=jnp.float32) / q))
    er = r.reshape(-1, 1) * freqs
    ec = col.reshape(-1, 1) * freqs
    return jnp.concatenate([jnp.sin(er), jnp.cos(er), jnp.sin(ec), jnp.cos(ec)], axis=-1)


def ffn_sublayer(h, mod, k0, g, w_gu, w_down):
    shift, scale, gate = mod[..., k0, :], mod[..., k0 + 1, :], mod[..., k0 + 2, :]
    n = rmsnorm(h, g) * (1 + scale) + shift
    gt, up = jnp.split(n @ w_gu, 2, axis=-1)
    return h + 0.5 * gate * ((jax.nn.silu(gt) * up) @ w_down)


def mix_in(h, mod, g, w_in):
    n = rmsnorm(h, g) * (1 + mod[..., 4, :]) + mod[..., 3, :]
    z = n @ w_in
    return jnp.split(z, [D_LRU, 2 * D_LRU, 2 * D_LRU + D_GMLP, 2 * D_LRU + 2 * D_GMLP], axis=-1)


def centred_conv(x, w, b):
    L = x.shape[1]
    left = CONV_W // 2
    right = CONV_W - 1 - left
    xp = jnp.pad(x, ((0, 0), (left, right), (0, 0)))
    return b + sum(xp[:, k:k + L] * w[k] for k in range(CONV_W))


def _lin_combine(e1, e2):
    a1, b1 = e1
    a2, b2 = e2
    return a1 * a2, a2 * b1 + b2


def rglru_direction(xc, w_g, b_g, lam, h0, reverse):
    B_, L, _ = xc.shape
    xh = xc.reshape(B_, L, N_LRU_HEADS, HEAD_DIM)
    gates = jnp.einsum("blhi,ghij->gblhj", xh, w_g).reshape(2, B_, L, D_LRU) + b_g[:, None, None, :]
    gates = gates.astype(jnp.float32)
    r = jax.nn.sigmoid(gates[0])
    i = jax.nn.sigmoid(gates[1])
    log_a = -LRU_C * r * jax.nn.softplus(-lam.astype(jnp.float32))
    a = jnp.exp(log_a)
    b = jnp.sqrt(-jnp.expm1(2.0 * log_a)) * i * xc.astype(jnp.float32)
    if h0 is not None:
        edge = -1 if reverse else 0
        b = b.at[:, edge].add(a[:, edge] * h0)
    _, h = lax.associative_scan(_lin_combine, (a, b), axis=1, reverse=reverse)
    final = h[:, 0] if reverse else h[:, -1]
    return h, final


def lru_branch(xa, conv_w, conv_b, w_gates, b_gates, lam, h0):
    xc = centred_conv(xa, conv_w, conv_b)
    hf, sf = rglru_direction(xc, w_gates[0], b_gates[0], lam[0], None if h0 is None else h0[0], False)
    hb, sb = rglru_direction(xc, w_gates[1], b_gates[1], lam[1], None if h0 is None else h0[1], True)
    return hf + hb, jnp.stack([sf, sb])


def gmlp_chunk(u, v, ws, bs):
    B_, L, _ = v.shape
    vc = v.reshape(B_, L // GMLP_CHUNK, GMLP_CHUNK, N_GMLP_GROUPS, D_GMLP // N_GMLP_GROUPS)
    mixed = jnp.einsum("gpq,bcqgd->bcpgd", ws, vc) + bs.T[None, None, :, :, None]
    return u * mixed.reshape(B_, L, D_GMLP)


def fourier_mix(f):
    B_, L, _ = f.shape
    fg = f.reshape(B_, L, N_FNET_GROUPS, D_FNET // N_FNET_GROUPS).astype(jnp.float32)
    y = jnp.fft.fft2(fg, axes=(1, 3), norm="ortho").real
    return y.reshape(B_, L, D_FNET).astype(f.dtype)


def mix_out(h, mod, y_lru, ga, u, v, f, ws, bs, w_out):
    y_a = y_lru.astype(h.dtype) * jax.nn.gelu(ga)
    y_b = gmlp_chunk(jax.nn.gelu(u), jax.nn.gelu(v), ws, bs)
    y_c = fourier_mix(f)
    y = jnp.concatenate([y_a, y_b, y_c], axis=-1) @ w_out
    return h + mod[..., 5, :] * y


def setup_inputs(seed: int = 0) -> dict:
    key = jax.random.key(seed)
    ks = jax.random.split(key, 20)

    def nrm(k, shape, scale):
        return scale * jax.random.normal(k, shape, jnp.float32)

    x = nrm(ks[0], (BATCH, SEQ, D_MODEL), 1.0)
    c = nrm(ks[1], (BATCH, D_MODEL), 1.0)
    ctx = nrm(ks[2], (BATCH, CTX_LEN, D_MODEL), 1.0)
    c_ctx = nrm(ks[3], (D_MODEL,), 1.0)
    w_mod = nrm(ks[4], (DEPTH, D_MODEL, N_MOD * D_MODEL), 0.5 * D_MODEL ** -0.5)
    b_mod = nrm(ks[5], (DEPTH, N_MOD * D_MODEL), 0.02)
    norm_g = 1.0 + nrm(ks[6], (DEPTH, 3, D_MODEL), 0.02)
    ffn_w_gu = nrm(ks[7], (DEPTH, 2, D_MODEL, 2 * D_FF), D_MODEL ** -0.5)
    ffn_w_down = nrm(ks[8], (DEPTH, 2, D_FF, D_MODEL), D_FF ** -0.5)
    w_in = nrm(ks[9], (DEPTH, D_MODEL, D_IN), D_MODEL ** -0.5)
    w_out = nrm(ks[10], (DEPTH, D_MIX, D_MODEL), D_MIX ** -0.5)
    conv_w = nrm(ks[11], (DEPTH, CONV_W, D_LRU), CONV_W ** -0.5)
    conv_b = nrm(ks[12], (DEPTH, D_LRU), 0.02)
    lru_w_gates = nrm(ks[13], (DEPTH, 2, 2, N_LRU_HEADS, HEAD_DIM, HEAD_DIM), HEAD_DIM ** -0.5)
    lru_b_gates = nrm(ks[14], (DEPTH, 2, 2, D_LRU), 0.02)
    a_c = jax.random.uniform(ks[15], (DEPTH, 2, D_LRU), jnp.float32, 0.9, 0.999)
    a = a_c ** (1.0 / LRU_C)
    lru_lambda = jnp.log(a) - jnp.log1p(-a)
    gmlp_ws = nrm(ks[16], (DEPTH, N_GMLP_GROUPS, GMLP_CHUNK, GMLP_CHUNK), GMLP_CHUNK ** -0.5)
    gmlp_bs = 1.0 + nrm(ks[17], (DEPTH, N_GMLP_GROUPS, GMLP_CHUNK), 0.02)
    final_norm_g = 1.0 + nrm(ks[18], (D_MODEL,), 0.02)
    return {"x": x, "c": c, "ctx": ctx, "c_ctx": c_ctx, "w_mod": w_mod, "b_mod": b_mod,
            "norm_g": norm_g, "ffn_w_gu": ffn_w_gu, "ffn_w_down": ffn_w_down,
            "w_in": w_in, "w_out": w_out, "conv_w": conv_w, "conv_b": conv_b,
            "lru_w_gates": lru_w_gates, "lru_b_gates": lru_b_gates, "lru_lambda": lru_lambda,
            "gmlp_ws": gmlp_ws, "gmlp_bs": gmlp_bs, "final_norm_g": final_norm_g}


def reference(x, c, ctx, c_ctx, w_mod, b_mod, norm_g, ffn_w_gu, ffn_w_down, w_in, w_out,
              conv_w, conv_b, lru_w_gates, lru_b_gates, lru_lambda, gmlp_ws, gmlp_bs,
              final_norm_g):
    rows = x.shape[1] // GRID_W
    h = x + sincos_2d(rows, D_MODEL).astype(x.dtype)[None]
    hc = ctx
    for l in range(DEPTH):
        last = l == DEPTH - 1
        mod = adaln(c, w_mod[l], b_mod[l])
        mod_c = adaln(c_ctx, w_mod[l], b_mod[l])

        h = ffn_sublayer(h, mod, 0, norm_g[l, 0], ffn_w_gu[l, 0], ffn_w_down[l, 0])
        hc = ffn_sublayer(hc, mod_c, 0, norm_g[l, 0], ffn_w_gu[l, 0], ffn_w_down[l, 0])

        xa_c, ga_c, u_c, v_c, f_c = mix_in(hc, mod_c, norm_g[l, 1], w_in[l])
        y_lru_c, state_c = lru_branch(xa_c, conv_w[l], conv_b[l], lru_w_gates[l],
                                      lru_b_gates[l], lru_lambda[l], None)
        xa, ga, u, v, f = mix_in(h, mod, norm_g[l, 1], w_in[l])
        y_lru, _ = lru_branch(xa, conv_w[l], conv_b[l], lru_w_gates[l],
                              lru_b_gates[l], lru_lambda[l], state_c)
        h = mix_out(h, mod, y_lru, ga, u, v, f, gmlp_ws[l], gmlp_bs[l], w_out[l])

        h = ffn_sublayer(h, mod, 6, norm_g[l, 2], ffn_w_gu[l, 1], ffn_w_down[l, 1])
        if not last:
            hc = mix_out(hc, mod_c, y_lru_c, ga_c, u_c, v_c, f_c, gmlp_ws[l], gmlp_bs[l], w_out[l])
            hc = ffn_sublayer(hc, mod_c, 6, norm_g[l, 2], ffn_w_gu[l, 1], ffn_w_down[l, 1])
    return rmsnorm(h, final_norm_g)
```

```cpp
#include <hip/hip_runtime.h>
#include <hip/hip_cooperative_groups.h>
#include <cstdio>
#include <cstdint>
namespace cg = cooperative_groups;

#define LAS __attribute__((address_space(3)))
#define GAS __attribute__((address_space(1)))
typedef unsigned short bf16_t;
typedef short bf16x8 __attribute__((ext_vector_type(8)));
typedef float f32x4 __attribute__((ext_vector_type(4)));
typedef float f32x2 __attribute__((ext_vector_type(2)));
typedef unsigned u32x4 __attribute__((ext_vector_type(4)));
typedef unsigned u32x2 __attribute__((ext_vector_type(2)));

constexpr int D = 1024, NB = 8, SEQ = 4096, CTXL = 256, TL = NB * SEQ, TC = NB * CTXL, T = TL + TC, NPAN = T / 256;
constexpr int DFF = 2816, ZW = 1280, YW = 1280, NMOD = 9;
constexpr int NQ = 68;

constexpr size_t SZ_WGU1 = (size_t)5632 * 1024 * 2, SZ_WDN1 = (size_t)1024 * 2816 * 2, SZ_WIN1 = (size_t)1792 * 1024 * 2, SZ_WOUT1 = (size_t)1024 * 1280 * 2;
constexpr size_t SZ_WGT1 = 131072 * 2, SZ_GWS1 = 65536 * 2;
constexpr size_t OFF_WGU = 0;
constexpr size_t OFF_WDN = OFF_WGU + 4 * SZ_WGU1;
constexpr size_t OFF_WIN = OFF_WDN + 4 * SZ_WDN1;
constexpr size_t OFF_WOUT = OFF_WIN + 2 * SZ_WIN1;
constexpr size_t OFF_WGT = OFF_WOUT + 2 * SZ_WOUT1;
constexpr size_t OFF_GWS = OFF_WGT + 2 * SZ_WGT1;
constexpr size_t OFF_MOD = OFF_GWS + 2 * SZ_GWS1;
constexpr size_t OFF_DFTM = OFF_MOD + (size_t)2 * 9 * 9216 * 4;
constexpr size_t OFF_DFTMC = OFF_DFTM + (size_t)8192 * 4096 * 2;
constexpr size_t OFF_HC = OFF_DFTMC + (size_t)512 * 256 * 2;
constexpr size_t OFF_XN = OFF_HC + (size_t)TC * 1024 * 4;
constexpr size_t OFF_AB = OFF_XN;
constexpr size_t OFF_AGG = OFF_AB + (size_t)T * 512 * 2 * 4;
constexpr size_t OFF_SP8 = OFF_AGG + (size_t)NB * NQ * 2 * 2 * 512 * 4;
constexpr size_t OFF_BAR = OFF_SP8 + 8192;
constexpr size_t OFF_PART = OFF_BAR + 16384;
constexpr size_t OFF_U = OFF_PART + (size_t)TC * 1024 * 4;
constexpr size_t OFF_ACT = OFF_U;
constexpr size_t OFF_Z = OFF_U;
constexpr size_t OFF_Y = OFF_Z + (size_t)T * ZW * 2;
constexpr size_t OFF_VT = OFF_Y + (size_t)T * YW * 2;
constexpr size_t OFF_VTC = OFF_VT + (size_t)NB * 256 * 4096 * 2;
constexpr size_t OFF_FT = OFF_VTC + (size_t)NB * 256 * 256 * 2;
constexpr size_t OFF_FTC = OFF_FT + (size_t)NB * 256 * 4096 * 2;
constexpr size_t U_END1 = OFF_FTC + (size_t)NB * 256 * 256 * 2;
constexpr size_t OFF_PART2 = OFF_FT;
constexpr size_t OFF_PART3 = OFF_FT + (size_t)TC * 1024 * 4;
static_assert(OFF_FT >= OFF_ACT + (size_t)T * DFF * 2 && OFF_PART3 + (size_t)TC * 1024 * 4 <= U_END1, "partial buffers must lie beyond ACT inside the FT region");
constexpr size_t U_END2 = OFF_ACT + (size_t)T * DFF * 2;
constexpr size_t WS_END = U_END1 > U_END2 ? U_END1 : U_END2;

constexpr int LDS_BYTES = 151552;

struct Params {
    const float *x, *c, *ctx, *c_ctx, *w_mod, *b_mod, *norm_g, *w_gu, *w_down, *w_in, *w_out, *conv_w, *conv_b, *lru_wg, *lru_bg, *lru_lam, *gmlp_ws, *gmlp_bs, *final_g;
    float* out; unsigned char* ws; int ph_lo, ph_hi;
};

__device__ __forceinline__ float bf2f(unsigned short b) { return __uint_as_float(((unsigned)b) << 16); }
__device__ __forceinline__ unsigned f2bf(float f) { unsigned u = __float_as_uint(f); return (u + 0x7fffu + ((u >> 16) & 1u)) >> 16; }
__device__ __forceinline__ unsigned cvt_pk_bf16(float lo, float hi) { unsigned r; asm volatile("v_cvt_pk_bf16_f32 %0, %1, %2" : "=v"(r) : "v"(lo), "v"(hi)); return r; }
__device__ __forceinline__ float wave_sum(float v) {
#pragma unroll
    for (int o = 1; o < 64; o <<= 1) v += __shfl_xor(v, o);
    return v;
}
__device__ __forceinline__ float silu_f(float g) { return g * __builtin_amdgcn_rcpf(1.0f + __expf(-g)); }
__device__ __forceinline__ float gelu_tanh_f(float x) { const float u = 1.5957691216f * (x + 0.044715f * x * x * x); return x * __builtin_amdgcn_rcpf(1.0f + __expf(-u)); }
__device__ __forceinline__ float sigmoid_fast(float x) { return __builtin_amdgcn_rcpf(1.0f + __expf(-x)); }

constexpr int BM = 256, BK = 64, HALF = 128, HTB = HALF * BK * 2, NXCD = 8, WGM = 8;
__device__ __forceinline__ int lds_byte(int r, int c) { const int st = (r >> 4) * 2 + (c >> 5), rr = r & 15, cc = c & 31, ob = rr * 64 + cc * 2; return st * 1024 + (ob ^ (((ob >> 9) & 1) << 5)); }
__device__ __forceinline__ void stage_rc(int b, int& R, int& C) { const int st = b / 1024, sb = b % 1024, swz = sb ^ (((sb >> 9) & 1) << 5); R = (st >> 1) * 16 + swz / 64; C = (st & 1) * 32 + (swz % 64) / 2; }
__device__ __forceinline__ int perm32(int rho) { const int n = rho >> 4, i = rho & 15; return 8 * (i >> 2) + 4 * n + (i & 3); }

struct Unit { const char* a; const char* b; int pm, pn, kind, pad; };

__device__ __forceinline__ bool tile_map(long L, int nM, int nN, int& pm, int& pn) {
    const int nwg = nM * nN; if (L >= nwg) return false;
    int wgid = (int)L; { const int q = nwg / NXCD, r = nwg % NXCD, xcd = wgid % NXCD, off = wgid / NXCD; wgid = (xcd < r ? xcd * (q + 1) : r * (q + 1) + (xcd - r) * q) + off; }
    const int nig = WGM * nN, gid = wgid / nig, fm = gid * WGM, gsz = (nM - fm) < WGM ? (nM - fm) : WGM;
    pm = fm + ((wgid % nig) % gsz); pn = (wgid % nig) / gsz; return true;
}
struct StaticOrder {
    const char* A; const char* Bt; int nM, nN, G, c; size_t tstep; int nt;
    __device__ __forceinline__ bool next(int i, Unit& u) const {
        int pm, pn; if (!tile_map((long)i * G + c, nM, nN, pm, pn)) return false;
        u.a = A + (size_t)pm * tstep; u.b = Bt + (size_t)pn * tstep; u.pm = pm; u.pn = pn; u.kind = 0; u.pad = nt; return true;
    }
};
struct SplitOrder {
    const char* A; const char* Bt; int ctx, G, c; size_t tstep; int nt;
    __device__ __forceinline__ bool next(int i, Unit& u) const {
        const int L = i * G + c;
        if (L < 512) { int pm, pn; tile_map(L, 128, 4, pm, pn); u.a = A + (size_t)pm * tstep; u.b = Bt + (size_t)pn * tstep; u.pm = pm; u.pn = pn; u.kind = 0; u.pad = nt; return true; }
        const int sidx = L - 512; if (sidx >= 64 * ctx) return false;
        int id, ks, t0, un;
        if (ctx == 1) { id = sidx >> 1; ks = sidx & 1; un = nt >> 1; t0 = ks * un; }
        else { id = sidx >> 2; ks = sidx & 3; const int qa = ((nt >> 2) + 1) & ~1, qb = (nt >> 1) - qa;
            t0 = ks == 0 ? 0 : ks == 1 ? qa : ks == 2 ? 2 * qa : 2 * qa + qb; un = ks < 2 ? qa : qb; }
        const int pm = 128 + (id >> 2), pn = id & 3; const size_t koff = (size_t)t0 * 128;
        u.a = A + (size_t)pm * tstep + koff; u.b = Bt + (size_t)pn * tstep + koff; u.pm = pm; u.pn = pn; u.kind = 1 + ks; u.pad = un; return true;
    }
};
struct InOrder {
    const char* XN; const char* W; int G, c;
    __device__ __forceinline__ bool next(int i, Unit& u) const {
        const size_t tstep = (size_t)256 * 1024 * 2; const long L = (long)i * G + c;
        if (L < NPAN * 5) { int pm, pn; tile_map(L, NPAN, 5, pm, pn); u.a = XN + (size_t)pm * tstep; u.b = W + (size_t)pn * tstep; u.pm = pm; u.pn = pn; u.kind = 0; u.pad = 16; return true; }
        const long L2 = L - NPAN * 5; if (L2 >= NPAN * 2) return false;
        const int which = (int)(L2 & 1), pnn = (int)(L2 >> 1);
        u.a = W + (size_t)(5 + which) * tstep; u.b = XN + (size_t)pnn * tstep; u.pm = which; u.pn = pnn; u.kind = 1; u.pad = 16; return true;
    }
};
struct DftOrder {
    const char* A; const char* FT; int G, c;
    __device__ __forceinline__ bool next(int i, Unit& u) const {
        if (i != 0 || c >= 128) return false;
        const int x = c & 7, qq = c >> 3, pi = 2 * x + (qq & 1), pm2 = pi < 8 ? pi : pi + 8, b = qq >> 1; const size_t tstep = (size_t)256 * 4096 * 2;
        u.a = A + (size_t)pm2 * tstep; u.b = FT + (size_t)b * tstep; u.pm = pm2; u.pn = b; u.kind = 0; u.pad = 64; return true;
    }
};
struct DftCOrder {
    const char* A; const char* FT; int G, c;
    __device__ __forceinline__ bool next(int i, Unit& u) const {
        const long L = (long)i * G + c; if (L >= 16) return false;
        const int pm2 = (int)(L & 1), b = (int)(L >> 1); const size_t tstep = (size_t)256 * 256 * 2;
        u.a = A + (size_t)pm2 * tstep; u.b = FT + (size_t)b * tstep; u.pm = pm2; u.pn = b; u.kind = 1; u.pad = 4; return true;
    }
};

__device__ __forceinline__ void store_bf16_tile(const f32x4 (&acc)[2][2][4][2], GAS bf16_t* p0, size_t ld, bool act, float scale) {
#pragma unroll
    for (int ai = 0; ai < 2; ++ai)
#pragma unroll
        for (int m = 0; m < 4; ++m) { GAS bf16_t* rowp = p0 + (size_t)(ai * HALF + m * 16) * ld;
#pragma unroll
            for (int bj = 0; bj < 2; ++bj) { f32x4 v0 = acc[ai][bj][m][0] * scale, v1 = acc[ai][bj][m][1] * scale;
                if (act) {
#pragma unroll
                    for (int j = 0; j < 4; ++j) { v0[j] = gelu_tanh_f(v0[j]); v1[j] = gelu_tanh_f(v1[j]); } }
                u32x4 w; w.x = cvt_pk_bf16(v0[0], v0[1]); w.y = cvt_pk_bf16(v0[2], v0[3]); w.z = cvt_pk_bf16(v1[0], v1[1]); w.w = cvt_pk_bf16(v1[2], v1[3]);
                *(GAS u32x4*)(rowp + bj * HALF) = w; } }
}
struct EpiGU {
    static constexpr bool PERM = true; bf16_t* ACT;
    __device__ __forceinline__ void operator()(const f32x4 (&acc)[2][2][4][2], const Unit& u, int wr, int wc, int fr, int fq) const {
        GAS bf16_t* p0 = (GAS bf16_t*)ACT + (size_t)(u.pm * BM + wr * 64 + fr) * DFF + u.pn * 128 + wc * 32 + 8 * fq;
#pragma unroll
        for (int ai = 0; ai < 2; ++ai)
#pragma unroll
            for (int m = 0; m < 4; ++m) { GAS bf16_t* rowp = p0 + (size_t)(ai * HALF + m * 16) * DFF;
                const f32x4 g0 = acc[ai][0][m][0], g1 = acc[ai][0][m][1], u0 = acc[ai][1][m][0], u1 = acc[ai][1][m][1]; f32x4 v0, v1;
#pragma unroll
                for (int j = 0; j < 4; ++j) { v0[j] = silu_f(g0[j]) * u0[j]; v1[j] = silu_f(g1[j]) * u1[j]; }
                u32x4 w; w.x = cvt_pk_bf16(v0[0], v0[1]); w.y = cvt_pk_bf16(v0[2], v0[3]); w.z = cvt_pk_bf16(v1[0], v1[1]); w.w = cvt_pk_bf16(v1[2], v1[3]);
                *(GAS u32x4*)rowp = w; }
    }
};
struct EpiRes {
    static constexpr bool PERM = false; float* Hl; float* Hc; const float* gate; float* PART; float mul; int padm;
    __device__ __forceinline__ void operator()(const f32x4 (&acc)[2][2][4][2], const Unit& u, int wr, int wc, int fr, int fq) const {
        const int vb = u.pm < 128 ? (u.pm >> 4) : 8;
        GAS float* base = (GAS float*)(u.pm < 128 ? Hl + (size_t)u.pm * 256 * 1024 : (u.kind >= 2 ? PART + (u.kind == 3 ? (size_t)((OFF_PART2 - OFF_PART) / 4) : u.kind == 4 ? (size_t)((OFF_PART3 - OFF_PART) / 4) : (size_t)0) : Hc) + (size_t)(u.pm - 128) * 256 * 1024);
        const int col0 = u.pn * BM + wc * 32 + 4 * fq; const GAS float* gp = (const GAS float*)gate + vb * 9216 + col0;
        GAS float* row0 = base + (size_t)(wr * 64 + fr) * 1024 + col0;
        if (u.kind >= 2) {
#pragma unroll
            for (int bj = 0; bj < 2; ++bj)
#pragma unroll
                for (int n = 0; n < 2; ++n) { const f32x4 gv = *(const GAS f32x4*)(gp + bj * HALF + n * 16) * mul;
#pragma unroll
                    for (int ai = 0; ai < 2; ++ai)
#pragma unroll
                        for (int m = 0; m < 4; ++m) *(GAS f32x4*)(row0 + (size_t)(ai * HALF + m * 16) * 1024 + bj * HALF + n * 16) = gv * acc[ai][bj][m][n]; }
            return; }
#pragma unroll
        for (int bj = 0; bj < 2; ++bj) {
            f32x4 hv[2][2][4];
#pragma unroll
            for (int n = 0; n < 2; ++n)
#pragma unroll
                for (int ai = 0; ai < 2; ++ai)
#pragma unroll
                    for (int m = 0; m < 4; ++m) hv[n][ai][m] = *(const GAS f32x4*)(row0 + (size_t)(ai * HALF + m * 16) * 1024 + bj * HALF + n * 16);
            asm volatile("" ::: "memory");
#pragma unroll
            for (int n = 0; n < 2; ++n) { const f32x4 gv = *(const GAS f32x4*)(gp + bj * HALF + n * 16) * mul;
#pragma unroll
                for (int ai = 0; ai < 2; ++ai)
#pragma unroll
                    for (int m = 0; m < 4; ++m) *(GAS f32x4*)(row0 + (size_t)(ai * HALF + m * 16) * 1024 + bj * HALF + n * 16) = hv[n][ai][m] + gv * acc[ai][bj][m][n]; }
            asm volatile("" ::: "memory"); }
    }
};
struct EpiIn {
    static constexpr bool PERM = true; bf16_t *Z, *VT, *VTC, *FT, *FTC;
    __device__ __forceinline__ void operator()(const f32x4 (&acc)[2][2][4][2], const Unit& u, int wr, int wc, int fr, int fq) const {
        GAS bf16_t* p0; size_t ld; bool act;
        if (u.kind == 0) { p0 = (GAS bf16_t*)Z + (size_t)(u.pm * BM + wr * 64 + fr) * ZW + u.pn * BM + wc * 32 + 8 * fq; ld = ZW; act = u.pn >= 2; }
        else { const int which = u.pm, pnn = u.pn; act = (which == 0);
            if (pnn < 128) { const int bb = pnn >> 4, n0 = (pnn & 15) * 256; ld = 4096; p0 = (GAS bf16_t*)(which ? FT : VT) + ((size_t)bb * 256 + wr * 64 + fr) * 4096 + n0 + wc * 32 + 8 * fq; }
            else { const int bb = pnn - 128; ld = 256; p0 = (GAS bf16_t*)(which ? FTC : VTC) + ((size_t)bb * 256 + wr * 64 + fr) * 256 + wc * 32 + 8 * fq; } }
        store_bf16_tile(acc, p0, ld, act, 1.0f);
    }
};
struct EpiDft {
    static constexpr bool PERM = true; bf16_t* Y;
    __device__ __forceinline__ void operator()(const f32x4 (&acc)[2][2][4][2], const Unit& u, int wr, int wc, int fr, int fq) const {
        if (u.kind == 0) {
            const int k0 = (u.pm & 15) * 256 + wr * 64 + fr, colbase = 768 + 256 * (u.pm >> 4); const unsigned flip = (u.pm >> 4) ? 0x80008000u : 0u; const float scale = 1.0f / 512.0f;
            GAS bf16_t* yb = (GAS bf16_t*)Y + (size_t)u.pn * 4096 * YW + colbase + wc * 32 + 8 * fq;
#pragma unroll
            for (int ai = 0; ai < 2; ++ai)
#pragma unroll
                for (int m = 0; m < 4; ++m) { const int k = k0 + ai * HALF + m * 16;
#pragma unroll
                    for (int bj = 0; bj < 2; ++bj) { const f32x4 v0 = acc[ai][bj][m][0] * scale, v1 = acc[ai][bj][m][1] * scale;
                        u32x4 w; w.x = cvt_pk_bf16(v0[0], v0[1]); w.y = cvt_pk_bf16(v0[2], v0[3]); w.z = cvt_pk_bf16(v1[0], v1[1]); w.w = cvt_pk_bf16(v1[2], v1[3]);
                        *(GAS u32x4*)(yb + (size_t)k * YW + bj * HALF) = w;
                        if (k != 0) { u32x4 wm; wm.x = w.x ^ flip; wm.y = w.y ^ flip; wm.z = w.z ^ flip; wm.w = w.w ^ flip; *(GAS u32x4*)(yb + (size_t)(4096 - k) * YW + bj * HALF) = wm; } } }
        } else {
            GAS bf16_t* p0 = (GAS bf16_t*)Y + (size_t)(TL + u.pn * 256 + wr * 64 + fr) * YW + 768 + 256 * u.pm + wc * 32 + 8 * fq;
            store_bf16_tile(acc, p0, YW, false, 1.0f / 128.0f);
        }
    }
};

template <class Epi, class Sched>
__device__ __forceinline__ void gemm_phase(LAS unsigned char* lds, const int K, const Sched& S, const Epi& E) {
    int tid = threadIdx.x; asm volatile("" : "+v"(tid));
    const int wid = __builtin_amdgcn_readfirstlane(tid >> 6), lane = tid & 63, wr = wid >> 2, wc = wid & 3, fr = lane & 15, fq = lane >> 4;
    unsigned voffA[2], voffB[2];
#pragma unroll
    for (int i = 0; i < 2; ++i) { int R, C; stage_rc(tid * 16 + i * 8192, R, C); const int Rb = Epi::PERM ? ((R & ~31) + perm32(R & 31)) : R;
        voffA[i] = (unsigned)(R * K + C) * 2u; voffB[i] = (unsigned)(Rb * K + C) * 2u; }
    const size_t kstep = (size_t)(BK * 2);
    const size_t hstep = (size_t)HALF * K * 2;
    const unsigned ldsw = (unsigned)wid * 1024u;
    const int aoff = lds_byte(wr * 64 + fr, fq * 8), boff = lds_byte(wc * 32 + fr, fq * 8);
#define PG8_SA(b, h) (((b) * 2 + (h)) * HTB)
#define PG8_SB(b, h) ((4 + (b) * 2 + (h)) * HTB)
#define PG8_STAGE(bufoff, gbase, voff) do { _Pragma("unroll") for (int _i = 0; _i < 2; ++_i) \
        __builtin_amdgcn_global_load_lds((const unsigned*)((const char*)(gbase) + (voff)[_i]), (LAS unsigned*)(lds + (bufoff) + ldsw + _i * 8192), 16, 0, 0); } while (0)
#define PG8_LDA(dst, b, h) do { _Pragma("unroll") for (int m = 0; m < 4; ++m) _Pragma("unroll") for (int k = 0; k < 2; ++k) dst[m][k] = *(const LAS bf16x8*)(lds + PG8_SA(b, h) + aoff + m * 2048 + k * 1024); } while (0)
#define PG8_LDB(dst, b, h) do { _Pragma("unroll") for (int n = 0; n < 2; ++n) _Pragma("unroll") for (int k = 0; k < 2; ++k) dst[n][k] = *(const LAS bf16x8*)(lds + PG8_SB(b, h) + boff + n * 2048 + k * 1024); } while (0)
#define PG8_MMA(ai, bj, At, Bt) do { __builtin_amdgcn_s_setprio(1); _Pragma("unroll") for (int m = 0; m < 4; ++m) _Pragma("unroll") for (int n = 0; n < 2; ++n) _Pragma("unroll") for (int k = 0; k < 2; ++k) \
        acc[ai][bj][m][n] = __builtin_amdgcn_mfma_f32_16x16x32_bf16(Bt[n][k], At[m][k], acc[ai][bj][m][n], 0, 0, 0); __builtin_amdgcn_s_setprio(0); } while (0)
#define PG8_WAIT_V(n) asm volatile("s_waitcnt vmcnt(" #n ")" ::: "memory")
#define PG8_WAIT_L(n) asm volatile("s_waitcnt lgkmcnt(" #n ")" ::: "memory")
#define PG8_BAR __builtin_amdgcn_s_barrier()
#define PG8_SCHED __builtin_amdgcn_sched_barrier(0)
    Unit cur, nxt; int ui = 0;
    if (!S.next(0, cur)) return;
    f32x4 acc[2][2][4][2];
#pragma unroll
    for (int a = 0; a < 2; ++a)
#pragma unroll
        for (int b = 0; b < 2; ++b)
#pragma unroll
            for (int m = 0; m < 4; ++m)
#pragma unroll
                for (int n = 0; n < 2; ++n) acc[a][b][m][n] = (f32x4){0.f, 0.f, 0.f, 0.f};
    bf16x8 At[4][2], B0[2][2], B1[2][2];
    const char* cA = cur.a; const char* cB = cur.b;
    PG8_STAGE(PG8_SB(0, 0), cB, voffB); PG8_STAGE(PG8_SB(0, 1), cB + hstep, voffB); PG8_STAGE(PG8_SA(0, 0), cA, voffA); PG8_STAGE(PG8_SA(0, 1), cA + hstep, voffA);
    if (wr == 1) PG8_BAR;
    PG8_WAIT_V(2); PG8_BAR;
    PG8_STAGE(PG8_SB(1, 0), cB + kstep, voffB); PG8_STAGE(PG8_SA(1, 0), cA + kstep, voffA); PG8_STAGE(PG8_SB(1, 1), cB + hstep + kstep, voffB);
    PG8_WAIT_V(6); PG8_BAR;
    for (;;) {
        const bool has_next = S.next(ui + 1, nxt);
        const char* nA = has_next ? nxt.a : cA; const char* nB = has_next ? nxt.b : cB;
        const int nt = cur.pad;
#pragma unroll 1
        for (int t = 0; t < nt; t += 2) {
            const bool last = (t == nt - 2);
            const char* a1 = cA + (size_t)(t + 1) * kstep;
            const char* a2 = last ? nA : cA + (size_t)(t + 2) * kstep; const char* b2 = last ? nB : cB + (size_t)(t + 2) * kstep;
            const char* a3 = a2 + kstep; const char* b3 = b2 + kstep;
            PG8_LDB(B0, 0, 0); PG8_LDB(B1, 0, 1); PG8_SCHED; PG8_LDA(At, 0, 0); PG8_STAGE(PG8_SA(1, 1), a1 + hstep, voffA);
            PG8_WAIT_V(8); PG8_WAIT_L(0); PG8_BAR; PG8_MMA(0, 0, At, B0); PG8_MMA(0, 1, At, B1); PG8_BAR; PG8_SCHED;
            PG8_LDA(At, 0, 1); PG8_STAGE(PG8_SB(0, 0), b2, voffB); PG8_STAGE(PG8_SB(0, 1), b2 + hstep, voffB); PG8_STAGE(PG8_SA(0, 0), a2, voffA);
            PG8_WAIT_V(8); PG8_WAIT_L(0); PG8_BAR; PG8_MMA(1, 0, At, B0); PG8_MMA(1, 1, At, B1); PG8_BAR; PG8_SCHED;
            PG8_LDB(B0, 1, 0); PG8_LDB(B1, 1, 1); PG8_SCHED; PG8_LDA(At, 1, 0); PG8_STAGE(PG8_SA(0, 1), a2 + hstep, voffA);
            PG8_WAIT_V(8); PG8_WAIT_L(0); PG8_BAR; PG8_MMA(0, 0, At, B0); PG8_MMA(0, 1, At, B1); PG8_BAR; PG8_SCHED;
            PG8_LDA(At, 1, 1); PG8_STAGE(PG8_SB(1, 0), b3, voffB); PG8_STAGE(PG8_SB(1, 1), b3 + hstep, voffB); PG8_STAGE(PG8_SA(1, 0), a3, voffA);
            PG8_WAIT_V(8); PG8_WAIT_L(0); PG8_BAR; PG8_MMA(1, 0, At, B0); PG8_MMA(1, 1, At, B1); PG8_BAR; PG8_SCHED;
        }
        if (wr == 0) PG8_BAR;
        E(acc, cur, wr, wc, fr, fq);
        if (!has_next) break;
#pragma unroll
        for (int a = 0; a < 2; ++a)
#pragma unroll
            for (int b = 0; b < 2; ++b)
#pragma unroll
                for (int m = 0; m < 4; ++m)
#pragma unroll
                    for (int n = 0; n < 2; ++n) acc[a][b][m][n] = (f32x4){0.f, 0.f, 0.f, 0.f};
        cur = nxt; cA = nA; cB = nB; ++ui;
        if (wr == 1) PG8_BAR;
    }
    PG8_WAIT_V(0);
    PG8_BAR;
#undef PG8_SA
#undef PG8_SB
#undef PG8_STAGE
#undef PG8_LDA
#undef PG8_LDB
#undef PG8_MMA
#undef PG8_WAIT_V
#undef PG8_WAIT_L
#undef PG8_BAR
#undef PG8_SCHED
}

__device__ __forceinline__ void transpose_item(const float* W, int ldw, int k0, int n0, bf16_t* WT, int ldt, int drow0, int dk0, LAS float* scr, int lane) {
    float tv[32];
#pragma unroll
    for (int i = 0; i < 32; ++i) { const int kk = 2 * i + (lane >> 5); tv[i] = W[(size_t)(k0 + kk) * ldw + n0 + (lane & 31)]; }
#pragma unroll
    for (int i = 0; i < 32; ++i) { const int kk = 2 * i + (lane >> 5); scr[kk * 33 + (lane & 31)] = tv[i]; }
    asm volatile("s_waitcnt lgkmcnt(0)" ::: "memory");
    const int c = lane & 7;
#pragma unroll
    for (int j = 0; j < 4; ++j) { const int n = (lane >> 3) + 8 * j; const LAS float* s = scr + (8 * c) * 33 + n;
        u32x4 o; o.x = cvt_pk_bf16(s[0 * 33], s[1 * 33]); o.y = cvt_pk_bf16(s[2 * 33], s[3 * 33]); o.z = cvt_pk_bf16(s[4 * 33], s[5 * 33]); o.w = cvt_pk_bf16(s[6 * 33], s[7 * 33]);
        *(GAS u32x4*)((GAS bf16_t*)WT + (size_t)(drow0 + n) * ldt + dk0 + 8 * c) = o; }
    asm volatile("s_waitcnt lgkmcnt(0)" ::: "memory");
}

__device__ __forceinline__ void prep_dft(const Params& P, LAS unsigned char* lds, int bid, int G) {
    int tid = threadIdx.x; asm volatile("" : "+v"(tid));
    unsigned char* ws = P.ws;
    LAS unsigned short* tabc = (LAS unsigned short*)(lds + 131072);
    LAS unsigned short* tabs = tabc + 4096;
    for (int i = tid; i < 4096; i += 512) { float s, c; sincospif((float)i * (1.0f / 2048.0f), &s, &c); tabc[i] = (unsigned short)f2bf(c); tabs[i] = (unsigned short)f2bf(s); }
    __syncthreads();
    { bf16_t* DFTM = (bf16_t*)(ws + OFF_DFTM);
      for (int rr = bid; rr < 4096; rr += G) { const int r = ((rr >> 11) << 12) + (rr & 2047); const int k = r & 4095;   const LAS unsigned short* tb = (r >> 12) ? tabs : tabc; const int n0 = tid * 8; unsigned e[8];
#pragma unroll
          for (int j = 0; j < 8; ++j) e[j] = tb[(k * (n0 + j)) & 4095];
          u32x4 o; o.x = e[0] | (e[1] << 16); o.y = e[2] | (e[3] << 16); o.z = e[4] | (e[5] << 16); o.w = e[6] | (e[7] << 16);
          *(GAS u32x4*)((GAS bf16_t*)DFTM + (size_t)r * 4096 + n0) = o; }
      bf16_t* DFTMC = (bf16_t*)(ws + OFF_DFTMC);
      for (int it = bid; it < 32; it += G) { const int r = it * 16 + (tid >> 5), n0 = (tid & 31) * 8, k = r & 255; const LAS unsigned short* tb = (r >> 8) ? tabs : tabc; unsigned e[8];
#pragma unroll
          for (int j = 0; j < 8; ++j) e[j] = tb[((k * (n0 + j)) & 255) << 4];
          u32x4 o; o.x = e[0] | (e[1] << 16); o.y = e[2] | (e[3] << 16); o.z = e[4] | (e[5] << 16); o.w = e[6] | (e[7] << 16);
          *(GAS u32x4*)((GAS bf16_t*)DFTMC + (size_t)r * 256 + n0) = o; } }
    __syncthreads();
}
__device__ __forceinline__ void prep_weights(const Params& P, LAS unsigned char* lds, int lay, int bid, int G, int sel) {
    int tid = threadIdx.x; asm volatile("" : "+v"(tid)); const int lane = tid & 63, wave = tid >> 6;
    unsigned char* ws = P.ws;
    LAS float* tab64 = (LAS float*)(lds + 131072 + 16384);
    if (tid < 64) tab64[tid] = cospif((float)tid * (1.0f / 32.0f));
    __syncthreads();
    { LAS float* scr = (LAS float*)(lds + wave * 16384);
      const int gw = bid * 8 + wave, NGW = G * 8;
      constexpr int I_GU = 16 * 176, I_DN = 44 * 32, I_IN = 16 * 56, I_OUT = 12 * 32;
      constexpr int NIT = 2 * I_GU + 2 * I_DN + I_IN + I_OUT;
      for (int it = gw; it < NIT; it += NGW) { int r = it;
          if (r < 2 * I_GU) { if (!((sel >> (r / I_GU)) & 1)) continue; const int mat = lay * 2 + r / I_GU, ii = r % I_GU, kb = ii / 176, nb = ii % 176, n0 = nb * 32;
              const int drow = n0 < DFF ? (n0 >> 7) * 256 + (n0 & 127) : ((n0 - DFF) >> 7) * 256 + 128 + ((n0 - DFF) & 127);
              transpose_item(P.w_gu + (size_t)mat * 1024 * 5632, 5632, kb * 64, n0, (bf16_t*)(ws + OFF_WGU + mat * SZ_WGU1), 1024, drow, kb * 64, scr, lane); continue; }
          r -= 2 * I_GU;
          if (r < 2 * I_DN) { if (!((sel >> (2 + r / I_DN)) & 1)) continue; const int mat = lay * 2 + r / I_DN, ii = r % I_DN, kb = ii / 32, nb = ii % 32;
              transpose_item(P.w_down + (size_t)mat * DFF * 1024, 1024, kb * 64, nb * 32, (bf16_t*)(ws + OFF_WDN + mat * SZ_WDN1), DFF, nb * 32, kb * 64, scr, lane); continue; }
          r -= 2 * I_DN;
          if (r < I_IN) { if (!(sel & 16)) continue; const int mat = lay, kb = r / 56, nb = r % 56;
              transpose_item(P.w_in + (size_t)mat * 1024 * 1792, 1792, kb * 64, nb * 32, (bf16_t*)(ws + OFF_WIN + mat * SZ_WIN1), 1024, nb * 32, kb * 64, scr, lane); continue; }
          r -= I_IN;
          if (sel & 32) { const int mat = lay, kb = r / 32, nb = r % 32;
              transpose_item(P.w_out + (size_t)mat * 1024 * 1024, 1024, kb * 64, nb * 32, (bf16_t*)(ws + OFF_WOUT + mat * SZ_WOUT1), 1280, nb * 32, kb * 64, scr, lane); } } }
    { const int gt = bid * 512 + tid, NGT = G * 512; const int l = lay;
      for (int idx = gt; idx < ((sel & 32) ? 256 * 1024 : 0); idx += NGT) { const int n = idx & 1023, gj = (idx >> 10) & 255, g = gj >> 6, j = gj & 63;
          const float* wp = P.w_out + (size_t)l * 1024 * 1024 + (size_t)(768 + g * 64) * 1024 + n; float cs = 0.f, sn = 0.f;
#pragma unroll 1
          for (int m0 = 0; m0 < 64; m0 += 32) { float wv[32];
#pragma unroll
              for (int m = 0; m < 32; ++m) wv[m] = wp[(size_t)(m0 + m) * 1024];
#pragma unroll
              for (int m = 0; m < 32; ++m) { const int t = ((m0 + m) * j) & 63; cs += tab64[t] * wv[m]; sn += tab64[(t + 48) & 63] * wv[m]; } }
          bf16_t* o = (bf16_t*)(ws + OFF_WOUT + l * SZ_WOUT1) + (size_t)n * 1280; o[768 + gj] = (bf16_t)f2bf(cs); o[1024 + gj] = (bf16_t)f2bf(-sn); }
      for (int i0 = gt; i0 < ((sel & 64) ? 131072 : 0); i0 += NGT) { const int idx = l * 131072 + i0; const int i = idx & 63, j = (idx >> 6) & 63, hi = idx >> 12;
          ((bf16_t*)(ws + OFF_WGT))[idx] = (bf16_t)f2bf(P.lru_wg[(size_t)hi * 4096 + i * 64 + j]); }
      for (int i0 = gt; i0 < ((sel & 64) ? 65536 : 0); i0 += NGT) { const int idx = l * 65536 + i0; ((bf16_t*)(ws + OFF_GWS))[idx] = (bf16_t)f2bf(P.gmlp_ws[idx]); } }
    __syncthreads();
}
__device__ __forceinline__ void phase_prep(const Params& P, LAS unsigned char* lds) {
    int tid = threadIdx.x; asm volatile("" : "+v"(tid)); const int lane = tid & 63, wave = tid >> 6, G = gridDim.x, bid = blockIdx.x;
    unsigned char* ws = P.ws;
    if (G == 256) { if (bid >= 144) prep_weights(P, lds, 0, bid - 144, 112, 1 | 4); } else prep_weights(P, lds, 0, bid, G, 1 | 4);
    { const int gt = bid * 512 + tid, NGT = G * 512;
      for (int idx = gt; idx < 2048; idx += NGT) ((float*)(ws + OFF_SP8))[idx] = 8.0f * log1pf(expf(-P.lru_lam[idx])); }
    __syncthreads();
    { LAS float* sc = (LAS float*)lds;
      LAS float* red = (LAS float*)(lds + 36864);
      for (int i = tid; i < 9 * 1024; i += 512) { const int v = i >> 10, k = i & 1023; const float cv = v < 8 ? P.c[v * 1024 + k] : P.c_ctx[k]; sc[i] = cv / (1.0f + expf(-cv)); }
      __syncthreads();
      float* MOD = (float*)(ws + OFF_MOD);
      for (int it = bid; it < 144; it += G) { const int l = it / 72, col0 = (it % 72) * 128, kc = tid >> 5, cq = tid & 31;
          f32x4 a[9];
#pragma unroll
          for (int v = 0; v < 9; ++v) a[v] = (f32x4){0.f, 0.f, 0.f, 0.f};
          const float* wp = P.w_mod + (size_t)l * 1024 * 9216 + (size_t)(kc * 64) * 9216 + col0 + 4 * cq;
#pragma unroll 1
          for (int k0 = 0; k0 < 64; k0 += 16) { f32x4 wv[16];
#pragma unroll
              for (int k = 0; k < 16; ++k) wv[k] = *(const f32x4*)(wp + (size_t)(k0 + k) * 9216);
#pragma unroll
              for (int k = 0; k < 16; ++k) {
#pragma unroll
                  for (int v = 0; v < 9; ++v) a[v] += wv[k] * sc[v * 1024 + kc * 64 + k0 + k]; } }
#pragma unroll
          for (int v = 0; v < 9; ++v) *(LAS f32x4*)(red + (kc * 9 + v) * 128 + 4 * cq) = a[v];
          __syncthreads();
          for (int o = tid; o < 9 * 128; o += 512) { const int v = o >> 7, cc = o & 127; float s = P.b_mod[l * 9216 + col0 + cc];
#pragma unroll
              for (int q = 0; q < 16; ++q) s += red[(q * 9 + v) * 128 + cc];
              MOD[(size_t)(l * 9 + v) * 9216 + col0 + cc] = s; }
          __syncthreads(); } }
}

__device__ __forceinline__ void norm_store(const f32x4 (&v)[4], const float* modv, int shift_k, int scale_k, const float* g, bf16_t* xnrow, int lane) {
    float ss = 0.f;
#pragma unroll
    for (int j = 0; j < 4; ++j) ss += (v[j].x * v[j].x + v[j].y * v[j].y) + (v[j].z * v[j].z + v[j].w * v[j].w);
    const float rstd = 1.0f / sqrtf(wave_sum(ss) * (1.0f / 1024.0f) + 1e-6f);
#pragma unroll
    for (int j = 0; j < 4; ++j) { const int c0 = 4 * lane + 256 * j;
        const f32x4 gg = *(const f32x4*)(g + c0), sc = *(const f32x4*)(modv + scale_k * 1024 + c0), sh = *(const f32x4*)(modv + shift_k * 1024 + c0);
        const f32x4 y = v[j] * rstd * gg * (sc + 1.0f) + sh;
        u32x2 w; w.x = cvt_pk_bf16(y.x, y.y); w.y = cvt_pk_bf16(y.z, y.w); *(GAS u32x2*)((GAS bf16_t*)xnrow + c0) = w; }
}
__device__ __forceinline__ void phase_init(const Params& P) {
    int tid = threadIdx.x; asm volatile("" : "+v"(tid)); const int lane = tid & 63, wave = tid >> 6, gw = blockIdx.x * 8 + wave, NGW = gridDim.x * 8;
    float* Hc = (float*)(P.ws + OFF_HC); bf16_t* XN = (bf16_t*)(P.ws + OFF_XN); const float* MOD = (const float*)(P.ws + OFF_MOD);
    float fr4[4];
#pragma unroll
    for (int e = 0; e < 4; ++e) fr4[e] = 1.0f / powf(10000.0f, (float)(4 * lane + e) * (1.0f / 256.0f));
    const int sA = gw & 4095, sB = (gw + NGW) & 4095; f32x4 posA[4], posB[4];
#pragma unroll
    for (int e = 0; e < 4; ++e) { float s1, c1, s2, c2;
        sincosf((float)(sA >> 6) * fr4[e], &s1, &c1); sincosf((float)(sA & 63) * fr4[e], &s2, &c2); posA[0][e] = s1; posA[1][e] = c1; posA[2][e] = s2; posA[3][e] = c2;
        sincosf((float)(sB >> 6) * fr4[e], &s1, &c1); sincosf((float)(sB & 63) * fr4[e], &s2, &c2); posB[0][e] = s1; posB[1][e] = c1; posB[2][e] = s2; posB[3][e] = c2; }
#define IN_LOAD(R, V, SC, SH) do { const int _r = (R); const float* _xr = _r < TL ? P.x + (size_t)_r * 1024 : P.ctx + (size_t)(_r - TL) * 1024; const float* _mv = MOD + (size_t)(_r < TL ? (_r >> 12) : 8) * 9216; \
        _Pragma("unroll") for (int j = 0; j < 4; ++j) { const int c0 = 4 * lane + 256 * j; V[j] = *(const f32x4*)(_xr + c0); SC[j] = *(const f32x4*)(_mv + 1024 + c0); SH[j] = *(const f32x4*)(_mv + c0); } } while (0)
    f32x4 gg[4], v[4], sc[4], sh[4];
#pragma unroll
    for (int j = 0; j < 4; ++j) gg[j] = *(const f32x4*)(P.norm_g + 4 * lane + 256 * j);
    if (gw < T) IN_LOAD(gw, v, sc, sh);
    for (int r = gw; r < T; r += NGW) { const int rn = r + NGW; f32x4 vn[4], scn[4], shn[4];
        if (rn < T) IN_LOAD(rn, vn, scn, shn);
        __builtin_amdgcn_sched_barrier(0);
        float* hr;
        if (r < TL) { const int s = r & 4095;
            if (s == sA) {
#pragma unroll
                for (int j = 0; j < 4; ++j) v[j] += posA[j];
            } else if (s == sB) {
#pragma unroll
                for (int j = 0; j < 4; ++j) v[j] += posB[j];
            } else { const float rr = (float)(s >> 6), cc = (float)(s & 63);
#pragma unroll
                for (int e = 0; e < 4; ++e) { float s1, c1, s2, c2; sincosf(rr * fr4[e], &s1, &c1); sincosf(cc * fr4[e], &s2, &c2); v[0][e] += s1; v[1][e] += c1; v[2][e] += s2; v[3][e] += c2; }
            }
            hr = P.out + (size_t)r * 1024; }
        else hr = Hc + (size_t)(r - TL) * 1024;
        float ss = 0.f;
#pragma unroll
        for (int j = 0; j < 4; ++j) { *(f32x4*)(hr + 4 * lane + 256 * j) = v[j]; ss += (v[j].x * v[j].x + v[j].y * v[j].y) + (v[j].z * v[j].z + v[j].w * v[j].w); }
        const float rstd = 1.0f / sqrtf(wave_sum(ss) * (1.0f / 1024.0f) + 1e-6f);
#pragma unroll
        for (int j = 0; j < 4; ++j) { const f32x4 y = v[j] * rstd * gg[j] * (sc[j] + 1.0f) + sh[j];
            u32x2 w; w.x = cvt_pk_bf16(y.x, y.y); w.y = cvt_pk_bf16(y.z, y.w); *(GAS u32x2*)((GAS bf16_t*)XN + (size_t)r * 1024 + 4 * lane + 256 * j) = w; }
        if (rn < T) {
#pragma unroll
            for (int j = 0; j < 4; ++j) { v[j] = vn[j]; sc[j] = scn[j]; sh[j] = shn[j]; } }
    }
#undef IN_LOAD
}
#define NR_LOAD(R, V, SC, SH) do { const int _r = (R); const float* _hr = _r < TL ? P.out + (size_t)_r * 1024 : Hc + (size_t)(_r - TL) * 1024; const float* _mv = MOD + (size_t)(_r < TL ? (_r >> 12) : 8) * 9216; \
        _Pragma("unroll") for (int j = 0; j < 4; ++j) { const int c0 = 4 * lane + 256 * j; V[j] = *(const f32x4*)(_hr + c0); SC[j] = *(const f32x4*)(_mv + (3 * sub + 1) * 1024 + c0); SH[j] = *(const f32x4*)(_mv + (3 * sub) * 1024 + c0); } \
        if (addpart && _r >= TL) { const size_t _o = (size_t)(_r - TL) * 1024; const float* _pr = (const float*)(P.ws + OFF_PART) + _o; _Pragma("unroll") for (int j = 0; j < 4; ++j) V[j] += *(const f32x4*)(_pr + 4 * lane + 256 * j); \
            if (addpart > 1) { const float* _p2 = (const float*)(P.ws + OFF_PART2) + _o; const float* _p3 = (const float*)(P.ws + OFF_PART3) + _o; _Pragma("unroll") for (int j = 0; j < 4; ++j) V[j] += *(const f32x4*)(_p2 + 4 * lane + 256 * j) + *(const f32x4*)(_p3 + 4 * lane + 256 * j); } } } while (0)
__device__ __forceinline__ void phase_norm(const Params& P, int l, int sub, int addpart) {
    int tid = threadIdx.x; asm volatile("" : "+v"(tid)); const int lane = tid & 63, wave = tid >> 6; const int rbeg = blockIdx.x * 8 + wave, rstride = gridDim.x * 8, rend = T;
    const float* Hc = (const float*)(P.ws + OFF_HC); bf16_t* XN = (bf16_t*)(P.ws + OFF_XN); const float* MOD = (const float*)(P.ws + OFF_MOD) + (size_t)l * 9 * 9216;
    const float* g = P.norm_g + (l * 3 + sub) * 1024; f32x4 gg[4];
#pragma unroll
    for (int j = 0; j < 4; ++j) gg[j] = *(const f32x4*)(g + 4 * lane + 256 * j);
    f32x4 v[4], sc[4], sh[4];
    if (rbeg < rend) NR_LOAD(rbeg, v, sc, sh);
    for (int r = rbeg; r < rend; r += rstride) { const int rn = r + rstride; f32x4 vn[4], scn[4], shn[4];
        if (rn < rend) NR_LOAD(rn, vn, scn, shn);
        __builtin_amdgcn_sched_barrier(0);
        if (addpart && r >= TL) { float* hw = (float*)(P.ws + OFF_HC) + (size_t)(r - TL) * 1024;
#pragma unroll
            for (int j = 0; j < 4; ++j) *(f32x4*)(hw + 4 * lane + 256 * j) = v[j]; }
        float ss = 0.f;
#pragma unroll
        for (int j = 0; j < 4; ++j) ss += (v[j].x * v[j].x + v[j].y * v[j].y) + (v[j].z * v[j].z + v[j].w * v[j].w);
        const float rstd = 1.0f / sqrtf(wave_sum(ss) * (1.0f / 1024.0f) + 1e-6f);
#pragma unroll
        for (int j = 0; j < 4; ++j) { const f32x4 y = v[j] * rstd * gg[j] * (sc[j] + 1.0f) + sh[j];
            u32x2 w; w.x = cvt_pk_bf16(y.x, y.y); w.y = cvt_pk_bf16(y.z, y.w); *(GAS u32x2*)((GAS bf16_t*)XN + (size_t)r * 1024 + 4 * lane + 256 * j) = w; }
        if (rn < rend) {
#pragma unroll
            for (int j = 0; j < 4; ++j) { v[j] = vn[j]; sc[j] = scn[j]; sh[j] = shn[j]; } }
    }
}
#undef NR_LOAD
__device__ __forceinline__ void phase_final(const Params& P) {
    int tid = threadIdx.x; asm volatile("" : "+v"(tid)); const int lane = tid & 63, wave = tid >> 6, gw = blockIdx.x * 8 + wave, NGW = gridDim.x * 8;
    f32x4 gg[4], v[4];
#pragma unroll
    for (int j = 0; j < 4; ++j) gg[j] = *(const f32x4*)(P.final_g + 4 * lane + 256 * j);
    if (gw < TL) {
#pragma unroll
        for (int j = 0; j < 4; ++j) v[j] = *(const f32x4*)(P.out + (size_t)gw * 1024 + 4 * lane + 256 * j); }
    for (int r = gw; r < TL; r += NGW) { float* hr = P.out + (size_t)r * 1024; const int rn = r + NGW; f32x4 vn[4];
        if (rn < TL) {
#pragma unroll
            for (int j = 0; j < 4; ++j) vn[j] = *(const f32x4*)(P.out + (size_t)rn * 1024 + 4 * lane + 256 * j); }
        __builtin_amdgcn_sched_barrier(0);
        float ss = 0.f;
#pragma unroll
        for (int j = 0; j < 4; ++j) ss += (v[j].x * v[j].x + v[j].y * v[j].y) + (v[j].z * v[j].z + v[j].w * v[j].w);
        const float rstd = 1.0f / sqrtf(wave_sum(ss) * (1.0f / 1024.0f) + 1e-6f);
#pragma unroll
        for (int j = 0; j < 4; ++j) *(f32x4*)(hr + 4 * lane + 256 * j) = v[j] * rstd * gg[j];
        if (rn < TL) {
#pragma unroll
            for (int j = 0; j < 4; ++j) v[j] = vn[j]; } }
}

__device__ __forceinline__ int queue_pull(unsigned* q, int lane) { unsigned nx = 0; if (lane == 0) nx = __hip_atomic_fetch_add(q, 1u, __ATOMIC_RELAXED, __HIP_MEMORY_SCOPE_AGENT); return 256 + (int)__builtin_amdgcn_readfirstlane(nx); }
__device__ __forceinline__ void gmlp_items(const Params& P, int l, int local, unsigned* q) {
    int tid = threadIdx.x; asm volatile("" : "+v"(tid)); const int lane = tid & 63, wslot = tid >> 6, fr = lane & 15, fq = lane >> 4;
    const GAS bf16_t* GWS = (const GAS bf16_t*)(P.ws + OFF_GWS + l * SZ_GWS1); const GAS bf16_t* Z = (const GAS bf16_t*)(P.ws + OFF_Z); GAS bf16_t* Y = (GAS bf16_t*)(P.ws + OFF_Y);
    const int xq = blockIdx.x & 7;
    for (; local < 680; local = queue_pull(q, lane)) { const int it = xq * 136 + (local - 544); const int ch = it >> 2, g = it & 3; const GAS bf16_t* VTb; int ldv;
        if (ch < 256) { const int b = ch >> 5, n0 = (ch & 31) * 128; VTb = (const GAS bf16_t*)(P.ws + OFF_VT) + ((size_t)b * 256 + g * 64) * 4096 + n0; ldv = 4096; }
        else { const int cc = ch - 256, b = cc >> 1, n0 = (cc & 1) * 128; VTb = (const GAS bf16_t*)(P.ws + OFF_VTC) + ((size_t)b * 256 + g * 64) * 256 + n0; ldv = 256; }
        bf16x8 Afv[4][4];
#pragma unroll
        for (int kk = 0; kk < 4; ++kk)
#pragma unroll
            for (int mt = 0; mt < 4; ++mt) Afv[kk][mt] = *(const GAS bf16x8*)(VTb + (size_t)(mt * 16 + fr) * ldv + kk * 32 + 8 * fq);
#pragma unroll 1
        for (int half = 0; half < 2; ++half) {
            bf16x8 Bfv[4][4]; u32x2 uua[4][4]; float bsv[4];
#pragma unroll
            for (int q = 0; q < 4; ++q) { const int p = 16 * (4 * half + q) + fr; const size_t row = (size_t)ch * 128 + p; bsv[q] = P.gmlp_bs[(l * 4 + g) * 128 + p];
#pragma unroll
                for (int kk = 0; kk < 4; ++kk) Bfv[q][kk] = *(const GAS bf16x8*)(GWS + ((size_t)(g * 128 + p)) * 128 + kk * 32 + 8 * fq);
#pragma unroll
                for (int mt = 0; mt < 4; ++mt) uua[q][mt] = *(const GAS u32x2*)(Z + row * ZW + 1024 + g * 64 + mt * 16 + 4 * fq); }
            __builtin_amdgcn_sched_barrier(0);
#pragma unroll
            for (int q = 0; q < 4; ++q) { const int p = 16 * (4 * half + q) + fr; const size_t row = (size_t)ch * 128 + p;
                f32x4 acc[4];
#pragma unroll
                for (int mt = 0; mt < 4; ++mt) acc[mt] = (f32x4){0.f, 0.f, 0.f, 0.f};
#pragma unroll
                for (int kk = 0; kk < 4; ++kk)
#pragma unroll
                    for (int mt = 0; mt < 4; ++mt) acc[mt] = __builtin_amdgcn_mfma_f32_16x16x32_bf16(Afv[kk][mt], Bfv[q][kk], acc[mt], 0, 0, 0);
#pragma unroll
                for (int mt = 0; mt < 4; ++mt) { const int d0 = mt * 16 + 4 * fq; const u32x2 uu = uua[q][mt];
                    const float u0 = __uint_as_float(uu.x << 16), u1 = __uint_as_float(uu.x & 0xffff0000u), u2 = __uint_as_float(uu.y << 16), u3 = __uint_as_float(uu.y & 0xffff0000u);
                    u32x2 o; o.x = cvt_pk_bf16(u0 * (acc[mt][0] + bsv[q]), u1 * (acc[mt][1] + bsv[q])); o.y = cvt_pk_bf16(u2 * (acc[mt][2] + bsv[q]), u3 * (acc[mt][3] + bsv[q]));
                    *(GAS u32x2*)(Y + row * YW + 512 + g * 64 + d0) = o; } }
        }
    }
}

__device__ __forceinline__ void dft_nyquist(const Params& P) {
    int tid = threadIdx.x; asm volatile("" : "+v"(tid)); const int lane = tid & 63;
    const GAS bf16_t* FT = (const GAS bf16_t*)(P.ws + OFF_FT); GAS bf16_t* Y = (GAS bf16_t*)(P.ws + OFF_Y);
    for (int wi = blockIdx.x * 8 + (tid >> 6); wi < NB * 256; wi += gridDim.x * 8) { const int b = wi >> 8, ch = wi & 255; const GAS bf16_t* fp = FT + ((size_t)b * 256 + ch) * 4096; float a = 0.f;
        u32x4 qv[8];
#pragma unroll
        for (int j = 0; j < 8; ++j) qv[j] = *(const GAS u32x4*)(fp + (size_t)(j * 64 + lane) * 8);
        __builtin_amdgcn_sched_barrier(0);
#pragma unroll
        for (int j = 0; j < 8; ++j) {
#pragma unroll
            for (int e = 0; e < 4; ++e) a += __uint_as_float(qv[j][e] << 16) - __uint_as_float(qv[j][e] & 0xffff0000u); }
        a = wave_sum(a);
        if (lane == 0) { GAS bf16_t* yr = Y + (size_t)(b * 4096 + 2048) * YW; yr[768 + ch] = (bf16_t)f2bf(a * (1.0f / 512.0f)); yr[1024 + ch] = (bf16_t)0; } }
}

__device__ __forceinline__ int lru_pass1(const Params& P, int l, LAS unsigned char* lds, unsigned* qw) {
    int tid = threadIdx.x; asm volatile("" : "+v"(tid)); const int lane = tid & 63, fr = lane & 15, fq = lane >> 4;
    const GAS bf16_t* Z = (const GAS bf16_t*)(P.ws + OFF_Z);
    const GAS bf16_t* WGT = (const GAS bf16_t*)(P.ws + OFF_WGT + l * SZ_WGT1); GAS float* AGG = (GAS float*)(P.ws + OFF_AGG); GAS unsigned* AB = (GAS unsigned*)(P.ws + OFF_AB);
    LAS unsigned short* xcS = (LAS unsigned short*)(lds + (tid >> 6) * 9216);
    LAS unsigned short* xaS = (LAS unsigned short*)(lds + 8 * 9216 + (tid >> 6) * 8704);
    const GAS float* SP8 = (const GAS float*)(P.ws + OFF_SP8);
    const int wslot = tid >> 6;
    const int xq = blockIdx.x & 7, jq = blockIdx.x >> 3;
    int local = jq >= 16 ? (jq - 16) * 8 + wslot : 128 + jq * 8 + wslot;
    for (;;) {
        if (local >= 544) break;
        const int wi = xq * 544 + local;
        const int it = wi >> 3, h = wi & 7;
        int b, j, q, Ls, r0seq;
        if (it < 512) { b = it >> 6; j = it & 63; q = 4 + j; Ls = 4096; r0seq = b * 4096; } else { const int t2 = it - 512; b = t2 >> 2; j = t2 & 3; q = j; Ls = 256; r0seq = TL + b * 256; }
        const int n0 = j * 64, r0 = r0seq + n0;
        {
            u32x4 tq[9];
#pragma unroll
            for (int jq = 0; jq < 9; ++jq) { const int qi = lane + 64 * jq, row = min(qi >> 3, 66), ch8 = qi & 7; const int n = n0 - 2 + row, nn = min(max(n, 0), Ls - 1);
                tq[jq] = *(const GAS u32x4*)(Z + (size_t)(r0seq + nn) * ZW + h * 64 + ch8 * 8); }
            __builtin_amdgcn_sched_barrier(0);
#pragma unroll
            for (int jq = 0; jq < 9; ++jq) { const int qi = lane + 64 * jq, row = qi >> 3, ch8 = qi & 7; if (row < 67) *(LAS u32x4*)(xaS + row * 64 + ch8 * 8) = tq[jq]; }
            asm volatile("s_waitcnt lgkmcnt(0)" ::: "memory");
            const int c = h * 64 + lane; const float* cw = P.conv_w + l * 4 * 512 + c; const float w0 = cw[0], w1 = cw[512], w2 = cw[1024], w3 = cw[1536], cb = P.conv_b[l * 512 + c];
            float xv[67];
#pragma unroll
            for (int i = 0; i < 67; ++i) { const int n = n0 - 2 + i; xv[i] = bf2f(xaS[i * 64 + lane]) * ((n >= 0 && n < Ls) ? 1.0f : 0.0f); }
#pragma unroll
            for (int p = 0; p < 64; ++p) { const float xc = cb + w0 * xv[p] + w1 * xv[p + 1] + w2 * xv[p + 2] + w3 * xv[p + 3]; xcS[p * 72 + lane] = (unsigned short)f2bf(xc); }
        }
        asm volatile("s_waitcnt lgkmcnt(0)" ::: "memory");
        bf16x8 Af[4][2];
#pragma unroll
        for (int mt = 0; mt < 4; ++mt)
#pragma unroll
            for (int kk = 0; kk < 2; ++kk) { const int row = 16 * (fr >> 2) + 4 * mt + (fr & 3); Af[mt][kk] = *(const LAS bf16x8*)(xcS + row * 72 + kk * 32 + 8 * fq); }
#pragma unroll 1
        for (int jt = 0; jt < 4; ++jt) { const int cl = 16 * jt + fr, c = h * 64 + cl;
            f32x4 acc[4][4];
#pragma unroll
            for (int mt = 0; mt < 4; ++mt)
#pragma unroll
                for (int dt = 0; dt < 4; ++dt) acc[mt][dt] = (f32x4){0.f, 0.f, 0.f, 0.f};
            bf16x8 Bfr[4][2];
#pragma unroll
            for (int dt = 0; dt < 4; ++dt)
#pragma unroll
                for (int kk = 0; kk < 2; ++kk) Bfr[dt][kk] = *(const GAS bf16x8*)(WGT + ((size_t)((dt * 8 + h) * 64 + cl)) * 64 + kk * 32 + 8 * fq);
            __builtin_amdgcn_sched_barrier(0);
#pragma unroll
            for (int dt = 0; dt < 4; ++dt)
#pragma unroll
                for (int kk = 0; kk < 2; ++kk) {
#pragma unroll
                    for (int mt = 0; mt < 4; ++mt) acc[mt][dt] = __builtin_amdgcn_mfma_f32_16x16x32_bf16(Af[mt][kk], Bfr[dt][kk], acc[mt][dt], 0, 0, 0); }
            u32x2 abw[16];
#pragma unroll
            for (int d = 0; d < 2; ++d) {
                const float bgr = P.lru_bg[((l * 2 + d) * 2 + 0) * 512 + c], bgi = P.lru_bg[((l * 2 + d) * 2 + 1) * 512 + c];
                const float sp8 = SP8[(l * 2 + d) * 512 + c];
#pragma unroll
                for (int mt = 0; mt < 4; ++mt)
#pragma unroll
                    for (int ip = 0; ip < 2; ++ip) { const int p = 16 * fq + 4 * mt + 2 * ip;
                        const f32x2 xcv = (f32x2){bf2f(xcS[p * 72 + cl]), bf2f(xcS[(p + 1) * 72 + cl])};
                        const f32x2 tr = ((f32x2){acc[mt][2 * d][2 * ip], acc[mt][2 * d][2 * ip + 1]} + bgr) * (-1.4426950408889634f);
                        const f32x2 ti = ((f32x2){acc[mt][2 * d + 1][2 * ip], acc[mt][2 * d + 1][2 * ip + 1]} + bgi) * (-1.4426950408889634f);
                        const f32x2 dr = (f32x2){__builtin_amdgcn_exp2f(tr.x), __builtin_amdgcn_exp2f(tr.y)} + 1.0f, di = (f32x2){__builtin_amdgcn_exp2f(ti.x), __builtin_amdgcn_exp2f(ti.y)} + 1.0f;
                        const f32x2 r = (f32x2){__builtin_amdgcn_rcpf(dr.x), __builtin_amdgcn_rcpf(dr.y)}, ig = (f32x2){__builtin_amdgcn_rcpf(di.x), __builtin_amdgcn_rcpf(di.y)};
                        const f32x2 la = r * (-sp8), x2 = la + la;
                        f32x2 q5 = x2 * 0.0083333333f + 0.041666668f; q5 = q5 * x2 + 0.16666667f; q5 = q5 * x2 + 0.5f; q5 = q5 * x2 + 1.0f; f32x2 em = -(x2 * q5);
                        if (__builtin_expect(__any((x2.x < -0.25f) || (x2.y < -0.25f)), 0)) {
                            if (x2.x < -0.25f) em.x = 1.0f - __expf(x2.x);
                            if (x2.y < -0.25f) em.y = 1.0f - __expf(x2.y); }
                        const f32x2 tl = la * 1.4426950408889634f; const f32x2 om = 1.0f - (f32x2){__builtin_amdgcn_exp2f(tl.x), __builtin_amdgcn_exp2f(tl.y)};
                        const f32x2 bvv = (f32x2){__builtin_amdgcn_sqrtf(em.x), __builtin_amdgcn_sqrtf(em.y)} * ig * xcv;
                        const unsigned wq0 = cvt_pk_bf16(om.x, bvv.x), wq1 = cvt_pk_bf16(om.y, bvv.y);
                        acc[mt][2 * d][2 * ip] = 1.0f - __uint_as_float(wq0 << 16); acc[mt][2 * d + 1][2 * ip] = __uint_as_float(wq0 & 0xffff0000u);
                        acc[mt][2 * d][2 * ip + 1] = 1.0f - __uint_as_float(wq1 << 16); acc[mt][2 * d + 1][2 * ip + 1] = __uint_as_float(wq1 & 0xffff0000u);
                        abw[mt * 4 + 2 * ip][d] = wq0; abw[mt * 4 + 2 * ip + 1][d] = wq1; }
                float Ar = 1.f, Br = 0.f;
#pragma unroll
                for (int s = 0; s < 16; ++s) { const int idx = d == 0 ? s : 15 - s; const float a = acc[idx >> 2][2 * d][idx & 3], bb = acc[idx >> 2][2 * d + 1][idx & 3]; Br = a * Br + bb; Ar *= a; }
                float Ac = 1.f, Bc = 0.f;
#pragma unroll
                for (int s = 0; s < 4; ++s) { const int f = d == 0 ? s : 3 - s; const float af = __shfl(Ar, fr + 16 * f), bf = __shfl(Br, fr + 16 * f); Bc = af * Bc + bf; Ac *= af; }
                if (fq == 0) { GAS float* ap = AGG + ((size_t)((b * NQ + q) * 2 + d) * 2) * 512 + c; ap[0] = Ac; ap[512] = Bc; }
            }
#pragma unroll
            for (int idx = 0; idx < 16; ++idx) *(GAS u32x2*)(AB + ((size_t)(r0 + 16 * fq + idx) * 512 + c) * 2) = abw[idx];
        }
        asm volatile("s_waitcnt lgkmcnt(0)" ::: "memory");
        local = queue_pull(qw, lane);
    }
    return local;
}
__device__ __forceinline__ void lru_scan(const Params& P, int l) {
    int tid = threadIdx.x; asm volatile("" : "+v"(tid)); const int c = tid;
    const GAS bf16_t* Z = (const GAS bf16_t*)(P.ws + OFF_Z); GAS bf16_t* Y = (GAS bf16_t*)(P.ws + OFF_Y);
    const GAS float* AGG = (const GAS float*)(P.ws + OFF_AGG); const GAS unsigned* AB = (const GAS unsigned*)(P.ws + OFF_AB);
    const int nitems = (l == 1) ? 512 : 544;
    for (int it = blockIdx.x; it < nitems; it += gridDim.x) {
        int b, j, q, r0seq;
        if (it < 512) { b = it >> 6; j = it & 63; q = 4 + j; r0seq = b * 4096; } else { const int t2 = it - 512; b = t2 >> 2; j = t2 & 3; q = j; r0seq = TL + b * 256; }
        const int r0 = r0seq + j * 64;
        float hin[2];
#pragma unroll
        for (int d = 0; d < 2; ++d) { const int rank = d == 0 ? q : (q < 4 ? 3 - q : 71 - q); float hh = 0.f;
#pragma unroll 1
            for (int r8 = 0; r8 < rank; r8 += 34) { float aa[34], bv[34];
#pragma unroll
                for (int k = 0; k < 34; ++k) { const int rho = r8 + k; const bool ok = rho < rank; const int rr = ok ? rho : 0; const int qq = d == 0 ? rr : (rr < 4 ? 3 - rr : 71 - rr);
                    const GAS float* ap = AGG + ((size_t)((b * NQ + qq) * 2 + d) * 2) * 512 + c; const float a0 = ap[0], b0 = ap[512]; aa[k] = ok ? a0 : 1.f; bv[k] = ok ? b0 : 0.f; }
#pragma unroll
                for (int k = 0; k < 34; ++k) hh = aa[k] * hh + bv[k]; }
            hin[d] = hh; }
        const GAS u32x2* abp = (const GAS u32x2*)(AB + ((size_t)r0 * 512 + c) * 2);
        u32x2 w[64];
#pragma unroll
        for (int p = 0; p < 64; ++p) w[p] = abp[(size_t)p * 512];
        float hf[64]; { float hh = hin[0];
#pragma unroll
            for (int p = 0; p < 64; ++p) { const float om = __uint_as_float(w[p].x << 16), bb = __uint_as_float(w[p].x & 0xffff0000u); hh = (hh - om * hh) + bb; hf[p] = hh; } }
        unsigned short gar[64];
#pragma unroll
        for (int p = 0; p < 64; ++p) gar[p] = Z[(size_t)(r0 + p) * ZW + 512 + c];
        { float hh = hin[1];
#pragma unroll
            for (int p = 63; p >= 0; --p) { const float om = __uint_as_float(w[p].y << 16), bb = __uint_as_float(w[p].y & 0xffff0000u); hh = (hh - om * hh) + bb;
                Y[(size_t)(r0 + p) * YW + c] = (bf16_t)f2bf((hf[p] + hh) * bf2f(gar[p])); } }
    }
}

#define XB_TMO      128
#define XB_XCNT(j)  (256  + 64 * (j))
#define XB_XSUB(j)  (1280 + 64 * (j))
#define XB_XGEN(j)  (2304 + 64 * (j))
#define XB_TOP      3328
#define XB_TOPGEN   3392
#define XCD_BAR_WORDS 3456
#define XB_SPIN_CAP (1u << 22)
__device__ __forceinline__ unsigned xb_ld(unsigned* p)              { return __hip_atomic_load(p, __ATOMIC_RELAXED, __HIP_MEMORY_SCOPE_AGENT); }
__device__ __forceinline__ unsigned xb_add(unsigned* p, unsigned v) { return __hip_atomic_fetch_add(p, v, __ATOMIC_RELAXED, __HIP_MEMORY_SCOPE_AGENT); }
__device__ __forceinline__ unsigned xb_xcc_id() { return (unsigned)__builtin_amdgcn_s_getreg((3 << 11) | 20) & 0xFu; }
#define XB_SPIN(cond, bar) do { unsigned _sp = 0; while (cond) { __builtin_amdgcn_s_sleep(1); \
    if ((++_sp & 255u) == 0u) { if (xb_ld(&(bar)[XB_TMO])) break; if (_sp > XB_SPIN_CAP) { atomicAdd(&(bar)[XB_TMO], 1u); break; } } } } while (0)
struct XcdBarrier { unsigned* bar; unsigned x; volatile LAS unsigned* st; };
__device__ __forceinline__ XcdBarrier xcd_barrier_post(unsigned* bar, volatile LAS unsigned* st) {
    XcdBarrier b; b.bar = bar; b.x = xb_xcc_id(); b.st = st;
    if (threadIdx.x == 0) (void)xb_add(&bar[XB_XCNT(b.x)], 1u);
    return b;
}
__device__ __forceinline__ void xcd_barrier_complete(unsigned* bar, unsigned x, unsigned& nloc, unsigned& nx) {
    const unsigned G = gridDim.x * gridDim.y * gridDim.z;
    unsigned sum, cnt, mine, sp = 0u;
    for (;;) {
        sum = 0u; cnt = 0u; mine = 0u;
#pragma unroll
        for (unsigned j = 0; j < 16; ++j) { const unsigned c = xb_ld(&bar[XB_XCNT(j)]); sum += c; cnt += (c > 0u) ? 1u : 0u; mine = (j == x) ? c : mine; }
        if (sum == G) break;
        __builtin_amdgcn_s_sleep(1);
        if ((++sp & 255u) == 0u) { if (xb_ld(&bar[XB_TMO])) break; if (sp > XB_SPIN_CAP) { atomicAdd(&bar[XB_TMO], 1u); break; } }
    }
    nloc = mine > 0u ? mine : 1u; nx = cnt > 0u ? cnt : 1u;
}
__device__ __forceinline__ void xcd_barrier(const XcdBarrier& b) {
    asm volatile("s_waitcnt vmcnt(0)" ::: "memory");
    __syncthreads();
    if (threadIdx.x == 0) {
        unsigned* bar = b.bar;
        __builtin_amdgcn_s_waitcnt(0);
        unsigned nloc = b.st[0], nx = b.st[1];
        if (nloc == 0u) { xcd_barrier_complete(bar, b.x, nloc, nx); b.st[0] = nloc; b.st[1] = nx; }
        const unsigned old = xb_add(&bar[XB_XSUB(b.x)], 1u);
        const unsigned gen = old / nloc;
        if (old + 1u == (gen + 1u) * nloc) {
            __builtin_amdgcn_fence(__ATOMIC_RELEASE, "agent");
            asm volatile("s_waitcnt vmcnt(0)" ::: "memory");
            const unsigned og = xb_add(&bar[XB_TOP], 1u);
            const unsigned tg = og / nx;
            if (og + 1u == (tg + 1u) * nx) xb_add(&bar[XB_TOPGEN], 1u);
            else XB_SPIN(xb_ld(&bar[XB_TOPGEN]) == tg, bar);
            __builtin_amdgcn_fence(__ATOMIC_ACQUIRE, "agent");
            xb_add(&bar[XB_XGEN(b.x)], 1u);
            asm volatile("s_waitcnt vmcnt(0)" ::: "memory");
        } else {
            XB_SPIN(xb_ld(&bar[XB_XGEN(b.x)]) == gen, bar);
            __builtin_amdgcn_fence(__ATOMIC_ACQUIRE, "agent");
            asm volatile("s_waitcnt vmcnt(0)" ::: "memory");
        }
    }
    __syncthreads();
}

__global__ void __launch_bounds__(512, 2) mega(Params P) {
    extern __shared__ __attribute__((aligned(16))) unsigned char lds_raw[];
    LAS unsigned char* lds = (LAS unsigned char*)lds_raw;
    cg::grid_group grid = cg::this_grid();
    unsigned char* ws = P.ws; const int G = gridDim.x, c = blockIdx.x;
    if (P.ph_lo < 0) grid.sync();
    volatile LAS unsigned* MISC = (volatile LAS unsigned*)(lds + 148480);
    if (threadIdx.x < 2) MISC[threadIdx.x] = 0u;
    __syncthreads();
    const XcdBarrier bar = xcd_barrier_post((unsigned*)(ws + OFF_BAR), MISC);
    int ph = 0;
#define RUN(...) do { if (ph >= P.ph_lo && ph < P.ph_hi) { __VA_ARGS__; if (ph + 1 < P.ph_hi) xcd_barrier(bar); } ++ph; } while (0)
    RUN(phase_prep(P, lds));
    RUN(phase_init(P));
    float* Hc = (float*)(ws + OFF_HC);
    for (int l = 0; l < 2; ++l) {
        const float* MODl = (const float*)(ws + OFF_MOD) + (size_t)l * 9 * 9216;
        for (int f = 0; f < 2; ++f) {
            if (f == 1) {
                RUN(phase_norm(P, l, 1, l == 1 ? 3 : 1));
                RUN({ InOrder S{(const char*)(ws + OFF_XN), (const char*)(ws + OFF_WIN + l * SZ_WIN1), G, c};
                      EpiIn E{(bf16_t*)(ws + OFF_Z), (bf16_t*)(ws + OFF_VT), (bf16_t*)(ws + OFF_VTC), (bf16_t*)(ws + OFF_FT), (bf16_t*)(ws + OFF_FTC)};
                      gemm_phase(lds, 1024, S, E); });
                RUN({ { DftOrder S{(const char*)(ws + OFF_DFTM), (const char*)(ws + OFF_FT), G, c}; EpiDft E{(bf16_t*)(ws + OFF_Y)}; gemm_phase(lds, 4096, S, E); }
                      if (l == 0) { DftCOrder S{(const char*)(ws + OFF_DFTMC), (const char*)(ws + OFF_FTC), G, c}; EpiDft E{(bf16_t*)(ws + OFF_Y)}; gemm_phase(lds, 256, S, E); }
                      __syncthreads();
                      dft_nyquist(P);
                      { unsigned* q = (unsigned*)(ws + OFF_BAR) + XCD_BAR_WORDS + 16 * (8 * l + (c & 7));
                        const int lg = lru_pass1(P, l, lds, q); gmlp_items(P, l, lg, q); } });
                RUN(lru_scan(P, l));
                RUN({ SplitOrder S{(const char*)(ws + OFF_Y), (const char*)(ws + OFF_WOUT + l * SZ_WOUT1), l == 1 ? 0 : 2, G, c, (size_t)256 * 1280 * 2, 20};
                      EpiRes E{P.out, Hc, MODl + 5 * 1024, (float*)(ws + OFF_PART), 1.0f, 0}; gemm_phase(lds, 1280, S, E); });
                RUN(phase_norm(P, l, 2, l == 0 ? 3 : 0));
            }
            RUN({ StaticOrder S{(const char*)(ws + OFF_XN), (const char*)(ws + OFF_WGU + (l * 2 + f) * SZ_WGU1), (l == 1 && f == 1) ? 128 : NPAN, 22, G, c, (size_t)256 * 1024 * 2, 16};
                  EpiGU E{(bf16_t*)(ws + OFF_ACT)}; gemm_phase(lds, 1024, S, E); });
            RUN({ SplitOrder S{(const char*)(ws + OFF_ACT), (const char*)(ws + OFF_WDN + (l * 2 + f) * SZ_WDN1), (l == 1 && f == 1) ? 0 : (l == 1 ? 2 : 1), G, c, (size_t)256 * DFF * 2, 44};
                  EpiRes E{P.out, Hc, MODl + (f == 0 ? 2 : 8) * 1024, (float*)(ws + OFF_PART), 0.5f, 0}; gemm_phase(lds, DFF, S, E);
                  if (l == 0 && c >= 64) { if (f == 0) { prep_dft(P, lds, c - 64, 192); prep_weights(P, lds, 0, c - 64, 192, 0x7f & ~(1 | 4)); } else prep_weights(P, lds, 1, c - 64, 192, 0x7f); } });
        }
        if (l == 0) RUN(phase_norm(P, 1, 0, 1)); else RUN(phase_final(P));
    }
#undef RUN
#ifdef PROBE
    xcd_barrier(bar);
#if PROBE == 1
    for (int i = 0; i < 40; ++i) xcd_barrier(bar);
#elif PROBE == 2
    for (int i = 0; i < 3; ++i) { gmlp_items(P, 1); lru_pass1(P, 1, lds); xcd_barrier(bar); lru_scan(P, 1); xcd_barrier(bar); }
#elif PROBE == 3
    for (int i = 0; i < 2; ++i) { phase_prep(P, lds); xcd_barrier(bar); }
#endif
#endif
}
constexpr int N_PHASES = 2 + 2 * 11;

extern "C" void kernel_launch(void* const* d_in, const int* in_sizes, int n_in, void* d_out, int out_size, void* d_ws, size_t ws_size, hipStream_t stream) {
    static int grid = 0;
    if (grid == 0) {
        if (n_in != 19 || out_size != TL * D || ws_size < WS_END) { fprintf(stderr, "kernel_launch: unexpected shapes (n_in %d out %d ws %zu need %zu)\n", n_in, out_size, ws_size, (size_t)WS_END); grid = -1; return; }
        int dev = 0, cus = 0, per_cu = 0;
        hipGetDevice(&dev); hipDeviceGetAttribute(&cus, hipDeviceAttributeMultiprocessorCount, dev);
        if (hipFuncSetAttribute((const void*)mega, hipFuncAttributeMaxDynamicSharedMemorySize, LDS_BYTES) != hipSuccess) { fprintf(stderr, "kernel_launch: hipFuncSetAttribute failed\n"); grid = -1; return; }
        hipOccupancyMaxActiveBlocksPerMultiprocessor(&per_cu, (const void*)mega, 512, LDS_BYTES);
        (void)hipGetLastError();
        if (per_cu < 1) per_cu = 1;
        grid = cus;
    }
    if (grid < 0) return;
    Params p{};
    p.x = (const float*)d_in[0]; p.c = (const float*)d_in[1]; p.ctx = (const float*)d_in[2]; p.c_ctx = (const float*)d_in[3]; p.w_mod = (const float*)d_in[4]; p.b_mod = (const float*)d_in[5];
    p.norm_g = (const float*)d_in[6]; p.w_gu = (const float*)d_in[7]; p.w_down = (const float*)d_in[8]; p.w_in = (const float*)d_in[9]; p.w_out = (const float*)d_in[10];
    p.conv_w = (const float*)d_in[11]; p.conv_b = (const float*)d_in[12]; p.lru_wg = (const float*)d_in[13]; p.lru_bg = (const float*)d_in[14]; p.lru_lam = (const float*)d_in[15];
    p.gmlp_ws = (const float*)d_in[16]; p.gmlp_bs = (const float*)d_in[17]; p.final_g = (const float*)d_in[18];
    p.out = (float*)d_out; p.ws = (unsigned char*)d_ws; p.ph_lo = 0; p.ph_hi = N_PHASES;
    if (hipMemsetAsync((char*)d_ws + OFF_BAR, 0, 16384, stream) != hipSuccess) { fprintf(stderr, "kernel_launch: hipMemsetAsync failed\n"); return; }
    void* args[] = {&p};
    hipError_t e = hipLaunchCooperativeKernel((const void*)mega, dim3(grid), dim3(512), args, LDS_BYTES, stream);
    if (e != hipSuccess) fprintf(stderr, "kernel_launch: cooperative launch failed: %s (grid %d)\n", hipGetErrorString(e), grid);
}
```

```cpp
#include <hip/hip_runtime.h>
#include <hip/hip_cooperative_groups.h>
#include <cstdio>
#include <cstdint>
namespace cg = cooperative_groups;

#define LAS __attribute__((address_space(3)))
#define GAS __attribute__((address_space(1)))
typedef unsigned short bf16_t;
typedef short bf16x8 __attribute__((ext_vector_type(8)));
typedef float f32x4 __attribute__((ext_vector_type(4)));
typedef float f32x2 __attribute__((ext_vector_type(2)));
typedef unsigned u32x4 __attribute__((ext_vector_type(4)));
typedef unsigned u32x2 __attribute__((ext_vector_type(2)));

constexpr int D = 1024, NB = 8, SEQ = 4096, CTXL = 256, TL = NB * SEQ, TC = NB * CTXL, T = TL + TC, NPAN = T / 256;
constexpr int DFF = 2816, ZW = 1280, YW = 1280, NMOD = 9;
constexpr int NQ = 68;

constexpr size_t SZ_WGU1 = (size_t)5632 * 1024 * 2, SZ_WDN1 = (size_t)1024 * 2816 * 2, SZ_WIN1 = (size_t)1792 * 1024 * 2, SZ_WOUT1 = (size_t)1024 * 1280 * 2;
constexpr size_t SZ_WGT1 = 131072 * 2, SZ_GWS1 = 65536 * 2;
constexpr size_t OFF_WGU = 0;
constexpr size_t OFF_WDN = OFF_WGU + 4 * SZ_WGU1;
constexpr size_t OFF_WIN = OFF_WDN + 4 * SZ_WDN1;
constexpr size_t OFF_WOUT = OFF_WIN + 2 * SZ_WIN1;
constexpr size_t OFF_WGT = OFF_WOUT + 2 * SZ_WOUT1;
constexpr size_t OFF_GWS = OFF_WGT + 2 * SZ_WGT1;
constexpr size_t OFF_MOD = OFF_GWS + 2 * SZ_GWS1;
constexpr size_t OFF_DFTM = OFF_MOD + (size_t)2 * 9 * 9216 * 4;
constexpr size_t OFF_DFTMC = OFF_DFTM + (size_t)8192 * 4096 * 2;
constexpr size_t OFF_HC = OFF_DFTMC + (size_t)512 * 256 * 2;
constexpr size_t OFF_XN = OFF_HC + (size_t)TC * 1024 * 4;
constexpr size_t OFF_AB = OFF_XN;
constexpr size_t OFF_AGG = OFF_AB + (size_t)T * 512 * 2 * 4;
constexpr size_t OFF_SP8 = OFF_AGG + (size_t)NB * NQ * 2 * 2 * 512 * 4;
constexpr size_t OFF_BAR = OFF_SP8 + 8192;
constexpr size_t OFF_PART = OFF_BAR + 16384;
constexpr size_t OFF_U = OFF_PART + (size_t)TC * 1024 * 4;
constexpr size_t OFF_ACT = OFF_U;
constexpr size_t OFF_Z = OFF_U;
constexpr size_t OFF_Y = OFF_Z + (size_t)T * ZW * 2;
constexpr size_t OFF_VT = OFF_Y + (size_t)T * YW * 2;
constexpr size_t OFF_VTC = OFF_VT + (size_t)NB * 256 * 4096 * 2;
constexpr size_t OFF_FT = OFF_VTC + (size_t)NB * 256 * 256 * 2;
constexpr size_t OFF_FTC = OFF_FT + (size_t)NB * 256 * 4096 * 2;
constexpr size_t U_END1 = OFF_FTC + (size_t)NB * 256 * 256 * 2;
constexpr size_t OFF_PART2 = OFF_FT;
constexpr size_t OFF_PART3 = OFF_FT + (size_t)TC * 1024 * 4;
static_assert(OFF_FT >= OFF_ACT + (size_t)T * DFF * 2 && OFF_PART3 + (size_t)TC * 1024 * 4 <= U_END1, "partial buffers must lie beyond ACT inside the FT region");
constexpr size_t U_END2 = OFF_ACT + (size_t)T * DFF * 2;
constexpr size_t WS_END = U_END1 > U_END2 ? U_END1 : U_END2;

constexpr int LDS_BYTES = 151552;

struct Params {
    const float *x, *c, *ctx, *c_ctx, *w_mod, *b_mod, *norm_g, *w_gu, *w_down, *w_in, *w_out, *conv_w, *conv_b, *lru_wg, *lru_bg, *lru_lam, *gmlp_ws, *gmlp_bs, *final_g;
    float* out; unsigned char* ws; int ph_lo, ph_hi;
};

__device__ __forceinline__ float bf2f(unsigned short b) { return __uint_as_float(((unsigned)b) << 16); }
__device__ __forceinline__ unsigned f2bf(float f) { unsigned u = __float_as_uint(f); return (u + 0x7fffu + ((u >> 16) & 1u)) >> 16; }
__device__ __forceinline__ unsigned cvt_pk_bf16(float lo, float hi) { unsigned r; asm volatile("v_cvt_pk_bf16_f32 %0, %1, %2" : "=v"(r) : "v"(lo), "v"(hi)); return r; }
__device__ __forceinline__ float wave_sum(float v) {
#pragma unroll
    for (int o = 1; o < 64; o <<= 1) v += __shfl_xor(v, o);
    return v;
}
__device__ __forceinline__ float silu_f(float g) { return g * __builtin_amdgcn_rcpf(1.0f + __expf(-g)); }
__device__ __forceinline__ float gelu_tanh_f(float x) { const float u = 1.5957691216f * (x + 0.044715f * x * x * x); return x * __builtin_amdgcn_rcpf(1.0f + __expf(-u)); }
__device__ __forceinline__ float sigmoid_fast(float x) { return __builtin_amdgcn_rcpf(1.0f + __expf(-x)); }

constexpr int BM = 256, BK = 64, HALF = 128, HTB = HALF * BK * 2, NXCD = 8, WGM = 8;
__device__ __forceinline__ int lds_byte(int r, int c) { const int st = (r >> 4) * 2 + (c >> 5), rr = r & 15, cc = c & 31, ob = rr * 64 + cc * 2; return st * 1024 + (ob ^ (((ob >> 9) & 1) << 5)); }
__device__ __forceinline__ void stage_rc(int b, int& R, int& C) { const int st = b / 1024, sb = b % 1024, swz = sb ^ (((sb >> 9) & 1) << 5); R = (st >> 1) * 16 + swz / 64; C = (st & 1) * 32 + (swz % 64) / 2; }
__device__ __forceinline__ int perm32(int rho) { const int n = rho >> 4, i = rho & 15; return 8 * (i >> 2) + 4 * n + (i & 3); }

struct Unit { const char* a; const char* b; int pm, pn, kind, pad; };

__device__ __forceinline__ bool tile_map(long L, int nM, int nN, int& pm, int& pn) {
    const int nwg = nM * nN; if (L >= nwg) return false;
    int wgid = (int)L; { const int q = nwg / NXCD, r = nwg % NXCD, xcd = wgid % NXCD, off = wgid / NXCD; wgid = (xcd < r ? xcd * (q + 1) : r * (q + 1) + (xcd - r) * q) + off; }
    const int nig = WGM * nN, gid = wgid / nig, fm = gid * WGM, gsz = (nM - fm) < WGM ? (nM - fm) : WGM;
    pm = fm + ((wgid % nig) % gsz); pn = (wgid % nig) / gsz; return true;
}
struct StaticOrder {
    const char* A; const char* Bt; int nM, nN, G, c; size_t tstep; int nt;
    __device__ __forceinline__ bool next(int i, Unit& u) const {
        int pm, pn; if (!tile_map((long)i * G + c, nM, nN, pm, pn)) return false;
        u.a = A + (size_t)pm * tstep; u.b = Bt + (size_t)pn * tstep; u.pm = pm; u.pn = pn; u.kind = 0; u.pad = nt; return true;
    }
};
struct SplitOrder {
    const char* A; const char* Bt; int ctx, G, c; size_t tstep; int nt;
    __device__ __forceinline__ bool next(int i, Unit& u) const {
        const int L = i * G + c;
        if (L < 512) { int pm, pn; tile_map(L, 128, 4, pm, pn); u.a = A + (size_t)pm * tstep; u.b = Bt + (size_t)pn * tstep; u.pm = pm; u.pn = pn; u.kind = 0; u.pad = nt; return true; }
        const int sidx = L - 512; if (sidx >= 64 * ctx) return false;
        int id, ks, t0, un;
        if (ctx == 1) { id = sidx >> 1; ks = sidx & 1; un = nt >> 1; t0 = ks * un; }
        else { id = sidx >> 2; ks = sidx & 3; const int qa = ((nt >> 2) + 1) & ~1, qb = (nt >> 1) - qa;
            t0 = ks == 0 ? 0 : ks == 1 ? qa : ks == 2 ? 2 * qa : 2 * qa + qb; un = ks < 2 ? qa : qb; }
        const int pm = 128 + (id >> 2), pn = id & 3; const size_t koff = (size_t)t0 * 128;
        u.a = A + (size_t)pm * tstep + koff; u.b = Bt + (size_t)pn * tstep + koff; u.pm = pm; u.pn = pn; u.kind = 1 + ks; u.pad = un; return true;
    }
};
struct InOrder {
    const char* XN; const char* W; int G, c;
    __device__ __forceinline__ bool next(int i, Unit& u) const {
        const size_t tstep = (size_t)256 * 1024 * 2; const long L = (long)i * G + c;
        if (L < NPAN * 5) { int pm, pn; tile_map(L, NPAN, 5, pm, pn); u.a = XN + (size_t)pm * tstep; u.b = W + (size_t)pn * tstep; u.pm = pm; u.pn = pn; u.kind = 0; u.pad = 16; return true; }
        const long L2 = L - NPAN * 5; if (L2 >= NPAN * 2) return false;
        const int which = (int)(L2 & 1), pnn = (int)(L2 >> 1);
        u.a = W + (size_t)(5 + which) * tstep; u.b = XN + (size_t)pnn * tstep; u.pm = which; u.pn = pnn; u.kind = 1; u.pad = 16; return true;
    }
};
struct DftOrder {
    const char* A; const char* FT; int G, c;
    __device__ __forceinline__ bool next(int i, Unit& u) const {
        if (i != 0 || c >= 128) return false;
        const int x = c & 7, qq = c >> 3, pi = 2 * x + (qq & 1), pm2 = pi < 8 ? pi : pi + 8, b = qq >> 1; const size_t tstep = (size_t)256 * 4096 * 2;
        u.a = A + (size_t)pm2 * tstep; u.b = FT + (size_t)b * tstep; u.pm = pm2; u.pn = b; u.kind = 0; u.pad = 64; return true;
    }
};
struct DftCOrder {
    const char* A; const char* FT; int G, c;
    __device__ __forceinline__ bool next(int i, Unit& u) const {
        const long L = (long)i * G + c; if (L >= 16) return false;
        const int pm2 = (int)(L & 1), b = (int)(L >> 1); const size_t tstep = (size_t)256 * 256 * 2;
        u.a = A + (size_t)pm2 * tstep; u.b = FT + (size_t)b * tstep; u.pm = pm2; u.pn = b; u.kind = 1; u.pad = 4; return true;
    }
};

__device__ __forceinline__ void store_bf16_tile(const f32x4 (&acc)[2][2][4][2], GAS bf16_t* p0, size_t ld, bool act, float scale) {
#pragma unroll
    for (int ai = 0; ai < 2; ++ai)
#pragma unroll
        for (int m = 0; m < 4; ++m) { GAS bf16_t* rowp = p0 + (size_t)(ai * HALF + m * 16) * ld;
#pragma unroll
            for (int bj = 0; bj < 2; ++bj) { f32x4 v0 = acc[ai][bj][m][0] * scale, v1 = acc[ai][bj][m][1] * scale;
                if (act) {
#pragma unroll
                    for (int j = 0; j < 4; ++j) { v0[j] = gelu_tanh_f(v0[j]); v1[j] = gelu_tanh_f(v1[j]); } }
                u32x4 w; w.x = cvt_pk_bf16(v0[0], v0[1]); w.y = cvt_pk_bf16(v0[2], v0[3]); w.z = cvt_pk_bf16(v1[0], v1[1]); w.w = cvt_pk_bf16(v1[2], v1[3]);
                *(GAS u32x4*)(rowp + bj * HALF) = w; } }
}
struct EpiGU {
    static constexpr bool PERM = true; bf16_t* ACT;
    __device__ __forceinline__ void operator()(const f32x4 (&acc)[2][2][4][2], const Unit& u, int wr, int wc, int fr, int fq) const {
        GAS bf16_t* p0 = (GAS bf16_t*)ACT + (size_t)(u.pm * BM + wr * 64 + fr) * DFF + u.pn * 128 + wc * 32 + 8 * fq;
#pragma unroll
        for (int ai = 0; ai < 2; ++ai)
#pragma unroll
            for (int m = 0; m < 4; ++m) { GAS bf16_t* rowp = p0 + (size_t)(ai * HALF + m * 16) * DFF;
                const f32x4 g0 = acc[ai][0][m][0], g1 = acc[ai][0][m][1], u0 = acc[ai][1][m][0], u1 = acc[ai][1][m][1]; f32x4 v0, v1;
#pragma unroll
                for (int j = 0; j < 4; ++j) { v0[j] = silu_f(g0[j]) * u0[j]; v1[j] = silu_f(g1[j]) * u1[j]; }
                u32x4 w; w.x = cvt_pk_bf16(v0[0], v0[1]); w.y = cvt_pk_bf16(v0[2], v0[3]); w.z = cvt_pk_bf16(v1[0], v1[1]); w.w = cvt_pk_bf16(v1[2], v1[3]);
                *(GAS u32x4*)rowp = w; }
    }
};
struct EpiRes {
    static constexpr bool PERM = false; float* Hl; float* Hc; const float* gate; float* PART; float mul; int padm;
    __device__ __forceinline__ void operator()(const f32x4 (&acc)[2][2][4][2], const Unit& u, int wr, int wc, int fr, int fq) const {
        const int vb = u.pm < 128 ? (u.pm >> 4) : 8;
        GAS float* base = (GAS float*)(u.pm < 128 ? Hl + (size_t)u.pm * 256 * 1024 : (u.kind >= 2 ? PART + (u.kind == 3 ? (size_t)((OFF_PART2 - OFF_PART) / 4) : u.kind == 4 ? (size_t)((OFF_PART3 - OFF_PART) / 4) : (size_t)0) : Hc) + (size_t)(u.pm - 128) * 256 * 1024);
        const int col0 = u.pn * BM + wc * 32 + 4 * fq; const GAS float* gp = (const GAS float*)gate + vb * 9216 + col0;
        GAS float* row0 = base + (size_t)(wr * 64 + fr) * 1024 + col0;
        if (u.kind >= 2) {
#pragma unroll
            for (int bj = 0; bj < 2; ++bj)
#pragma unroll
                for (int n = 0; n < 2; ++n) { const f32x4 gv = *(const GAS f32x4*)(gp + bj * HALF + n * 16) * mul;
#pragma unroll
                    for (int ai = 0; ai < 2; ++ai)
#pragma unroll
                        for (int m = 0; m < 4; ++m) *(GAS f32x4*)(row0 + (size_t)(ai * HALF + m * 16) * 1024 + bj * HALF + n * 16) = gv * acc[ai][bj][m][n]; }
            return; }
#pragma unroll
        for (int bj = 0; bj < 2; ++bj) {
            f32x4 hv[2][2][4];
#pragma unroll
            for (int n = 0; n < 2; ++n)
#pragma unroll
                for (int ai = 0; ai < 2; ++ai)
#pragma unroll
                    for (int m = 0; m < 4; ++m) hv[n][ai][m] = *(const GAS f32x4*)(row0 + (size_t)(ai * HALF + m * 16) * 1024 + bj * HALF + n * 16);
            asm volatile("" ::: "memory");
#pragma unroll
            for (int n = 0; n < 2; ++n) { const f32x4 gv = *(const GAS f32x4*)(gp + bj * HALF + n * 16) * mul;
#pragma unroll
                for (int ai = 0; ai < 2; ++ai)
#pragma unroll
                    for (int m = 0; m < 4; ++m) *(GAS f32x4*)(row0 + (size_t)(ai * HALF + m * 16) * 1024 + bj * HALF + n * 16) = hv[n][ai][m] + gv * acc[ai][bj][m][n]; }
            asm volatile("" ::: "memory"); }
    }
};
struct EpiIn {
    static constexpr bool PERM = true; bf16_t *Z, *VT, *VTC, *FT, *FTC;
    __device__ __forceinline__ void operator()(const f32x4 (&acc)[2][2][4][2], const Unit& u, int wr, int wc, int fr, int fq) const {
        GAS bf16_t* p0; size_t ld; bool act;
        if (u.kind == 0) { p0 = (GAS bf16_t*)Z + (size_t)(u.pm * BM + wr * 64 + fr) * ZW + u.pn * BM + wc * 32 + 8 * fq; ld = ZW; act = u.pn >= 2; }
        else { const int which = u.pm, pnn = u.pn; act = (which == 0);
            if (pnn < 128) { const int bb = pnn >> 4, n0 = (pnn & 15) * 256; ld = 4096; p0 = (GAS bf16_t*)(which ? FT : VT) + ((size_t)bb * 256 + wr * 64 + fr) * 4096 + n0 + wc * 32 + 8 * fq; }
            else { const int bb = pnn - 128; ld = 256; p0 = (GAS bf16_t*)(which ? FTC : VTC) + ((size_t)bb * 256 + wr * 64 + fr) * 256 + wc * 32 + 8 * fq; } }
        store_bf16_tile(acc, p0, ld, act, 1.0f);
    }
};
struct EpiDft {
    static constexpr bool PERM = true; bf16_t* Y;
    __device__ __forceinline__ void operator()(const f32x4 (&acc)[2][2][4][2], const Unit& u, int wr, int wc, int fr, int fq) const {
        if (u.kind == 0) {
            const int k0 = (u.pm & 15) * 256 + wr * 64 + fr, colbase = 768 + 256 * (u.pm >> 4); const unsigned flip = (u.pm >> 4) ? 0x80008000u : 0u; const float scale = 1.0f / 512.0f;
            GAS bf16_t* yb = (GAS bf16_t*)Y + (size_t)u.pn * 4096 * YW + colbase + wc * 32 + 8 * fq;
#pragma unroll
            for (int ai = 0; ai < 2; ++ai)
#pragma unroll
                for (int m = 0; m < 4; ++m) { const int k = k0 + ai * HALF + m * 16;
#pragma unroll
                    for (int bj = 0; bj < 2; ++bj) { const f32x4 v0 = acc[ai][bj][m][0] * scale, v1 = acc[ai][bj][m][1] * scale;
                        u32x4 w; w.x = cvt_pk_bf16(v0[0], v0[1]); w.y = cvt_pk_bf16(v0[2], v0[3]); w.z = cvt_pk_bf16(v1[0], v1[1]); w.w = cvt_pk_bf16(v1[2], v1[3]);
                        *(GAS u32x4*)(yb + (size_t)k * YW + bj * HALF) = w;
                        if (k != 0) { u32x4 wm; wm.x = w.x ^ flip; wm.y = w.y ^ flip; wm.z = w.z ^ flip; wm.w = w.w ^ flip; *(GAS u32x4*)(yb + (size_t)(4096 - k) * YW + bj * HALF) = wm; } } }
        } else {
            GAS bf16_t* p0 = (GAS bf16_t*)Y + (size_t)(TL + u.pn * 256 + wr * 64 + fr) * YW + 768 + 256 * u.pm + wc * 32 + 8 * fq;
            store_bf16_tile(acc, p0, YW, false, 1.0f / 128.0f);
        }
    }
};

template <class Epi, class Sched>
__device__ __forceinline__ void gemm_phase(LAS unsigned char* lds, const int K, const Sched& S, const Epi& E) {
    int tid = threadIdx.x; asm volatile("" : "+v"(tid));
    const int wid = __builtin_amdgcn_readfirstlane(tid >> 6), lane = tid & 63, wr = wid >> 2, wc = wid & 3, fr = lane & 15, fq = lane >> 4;
    unsigned voffA[2], voffB[2];
#pragma unroll
    for (int i = 0; i < 2; ++i) { int R, C; stage_rc(tid * 16 + i * 8192, R, C); const int Rb = Epi::PERM ? ((R & ~31) + perm32(R & 31)) : R;
        voffA[i] = (unsigned)(R * K + C) * 2u; voffB[i] = (unsigned)(Rb * K + C) * 2u; }
    const size_t kstep = (size_t)(BK * 2);
    const size_t hstep = (size_t)HALF * K * 2;
    const unsigned ldsw = (unsigned)wid * 1024u;
    const int aoff = lds_byte(wr * 64 + fr, fq * 8), boff = lds_byte(wc * 32 + fr, fq * 8);
#define PG8_SA(b, h) (((b) * 2 + (h)) * HTB)
#define PG8_SB(b, h) ((4 + (b) * 2 + (h)) * HTB)
#define PG8_STAGE(bufoff, gbase, voff) do { _Pragma("unroll") for (int _i = 0; _i < 2; ++_i) \
        __builtin_amdgcn_global_load_lds((const unsigned*)((const char*)(gbase) + (voff)[_i]), (LAS unsigned*)(lds + (bufoff) + ldsw + _i * 8192), 16, 0, 0); } while (0)
#define PG8_LDA(dst, b, h) do { _Pragma("unroll") for (int m = 0; m < 4; ++m) _Pragma("unroll") for (int k = 0; k < 2; ++k) dst[m][k] = *(const LAS bf16x8*)(lds + PG8_SA(b, h) + aoff + m * 2048 + k * 1024); } while (0)
#define PG8_LDB(dst, b, h) do { _Pragma("unroll") for (int n = 0; n < 2; ++n) _Pragma("unroll") for (int k = 0; k < 2; ++k) dst[n][k] = *(const LAS bf16x8*)(lds + PG8_SB(b, h) + boff + n * 2048 + k * 1024); } while (0)
#define PG8_MMA(ai, bj, At, Bt) do { __builtin_amdgcn_s_setprio(1); _Pragma("unroll") for (int m = 0; m < 4; ++m) _Pragma("unroll") for (int n = 0; n < 2; ++n) _Pragma("unroll") for (int k = 0; k < 2; ++k) \
        acc[ai][bj][m][n] = __builtin_amdgcn_mfma_f32_16x16x32_bf16(Bt[n][k], At[m][k], acc[ai][bj][m][n], 0, 0, 0); __builtin_amdgcn_s_setprio(0); } while (0)
#define PG8_WAIT_V(n) asm volatile("s_waitcnt vmcnt(" #n ")" ::: "memory")
#define PG8_WAIT_L(n) asm volatile("s_waitcnt lgkmcnt(" #n ")" ::: "memory")
#define PG8_BAR __builtin_amdgcn_s_barrier()
#define PG8_SCHED __builtin_amdgcn_sched_barrier(0)
    Unit cur, nxt; int ui = 0;
    if (!S.next(0, cur)) return;
    f32x4 acc[2][2][4][2];
#pragma unroll
    for (int a = 0; a < 2; ++a)
#pragma unroll
        for (int b = 0; b < 2; ++b)
#pragma unroll
            for (int m = 0; m < 4; ++m)
#pragma unroll
                for (int n = 0; n < 2; ++n) acc[a][b][m][n] = (f32x4){0.f, 0.f, 0.f, 0.f};
    bf16x8 At[4][2], B0[2][2], B1[2][2];
    const char* cA = cur.a; const char* cB = cur.b;
    PG8_STAGE(PG8_SB(0, 0), cB, voffB); PG8_STAGE(PG8_SB(0, 1), cB + hstep, voffB); PG8_STAGE(PG8_SA(0, 0), cA, voffA); PG8_STAGE(PG8_SA(0, 1), cA + hstep, voffA);
    if (wr == 1) PG8_BAR;
    PG8_WAIT_V(2); PG8_BAR;
    PG8_STAGE(PG8_SB(1, 0), cB + kstep, voffB); PG8_STAGE(PG8_SA(1, 0), cA + kstep, voffA); PG8_STAGE(PG8_SB(1, 1), cB + hstep + kstep, voffB);
    PG8_WAIT_V(6); PG8_BAR;
    for (;;) {
        const bool has_next = S.next(ui + 1, nxt);
        const char* nA = has_next ? nxt.a : cA; const char* nB = has_next ? nxt.b : cB;
        const int nt = cur.pad;
#pragma unroll 1
        for (int t = 0; t < nt; t += 2) {
            const bool last = (t == nt - 2);
            const char* a1 = cA + (size_t)(t + 1) * kstep;
            const char* a2 = last ? nA : cA + (size_t)(t + 2) * kstep; const char* b2 = last ? nB : cB + (size_t)(t + 2) * kstep;
            const char* a3 = a2 + kstep; const char* b3 = b2 + kstep;
            PG8_LDB(B0, 0, 0); PG8_LDB(B1, 0, 1); PG8_SCHED; PG8_LDA(At, 0, 0); PG8_STAGE(PG8_SA(1, 1), a1 + hstep, voffA);
            PG8_WAIT_V(8); PG8_WAIT_L(0); PG8_BAR; PG8_MMA(0, 0, At, B0); PG8_MMA(0, 1, At, B1); PG8_BAR; PG8_SCHED;
            PG8_LDA(At, 0, 1); PG8_STAGE(PG8_SB(0, 0), b2, voffB); PG8_STAGE(PG8_SB(0, 1), b2 + hstep, voffB); PG8_STAGE(PG8_SA(0, 0), a2, voffA);
            PG8_WAIT_V(8); PG8_WAIT_L(0); PG8_BAR; PG8_MMA(1, 0, At, B0); PG8_MMA(1, 1, At, B1); PG8_BAR; PG8_SCHED;
            PG8_LDB(B0, 1, 0); PG8_LDB(B1, 1, 1); PG8_SCHED; PG8_LDA(At, 1, 0); PG8_STAGE(PG8_SA(0, 1), a2 + hstep, voffA);
            PG8_WAIT_V(8); PG8_WAIT_L(0); PG8_BAR; PG8_MMA(0, 0, At, B0); PG8_MMA(0, 1, At, B1); PG8_BAR; PG8_SCHED;
            PG8_LDA(At, 1, 1); PG8_STAGE(PG8_SB(1, 0), b3, voffB); PG8_STAGE(PG8_SB(1, 1), b3 + hstep, voffB); PG8_STAGE(PG8_SA(1, 0), a3, voffA);
            PG8_WAIT_V(8); PG8_WAIT_L(0); PG8_BAR; PG8_MMA(1, 0, At, B0); PG8_MMA(1, 1, At, B1); PG8_BAR; PG8_SCHED;
        }
        if (wr == 0) PG8_BAR;
        E(acc, cur, wr, wc, fr, fq);
        if (!has_next) break;
#pragma unroll
        for (int a = 0; a < 2; ++a)
#pragma unroll
            for (int b = 0; b < 2; ++b)
#pragma unroll
                for (int m = 0; m < 4; ++m)
#pragma unroll
                    for (int n = 0; n < 2; ++n) acc[a][b][m][n] = (f32x4){0.f, 0.f, 0.f, 0.f};
        cur = nxt; cA = nA; cB = nB; ++ui;
        if (wr == 1) PG8_BAR;
    }
    PG8_WAIT_V(0);
    PG8_BAR;
#undef PG8_SA
#undef PG8_SB
#undef PG8_STAGE
#undef PG8_LDA
#undef PG8_LDB
#undef PG8_MMA
#undef PG8_WAIT_V
#undef PG8_WAIT_L
#undef PG8_BAR
#undef PG8_SCHED
}

__device__ __forceinline__ void transpose_item(const float* W, int ldw, int k0, int n0, bf16_t* WT, int ldt, int drow0, int dk0, LAS float* scr, int lane) {
    float tv[32];
#pragma unroll
    for (int i = 0; i < 32; ++i) { const int kk = 2 * i + (lane >> 5); tv[i] = W[(size_t)(k0 + kk) * ldw + n0 + (lane & 31)]; }
#pragma unroll
    for (int i = 0; i < 32; ++i) { const int kk = 2 * i + (lane >> 5); scr[kk * 33 + (lane & 31)] = tv[i]; }
    asm volatile("s_waitcnt lgkmcnt(0)" ::: "memory");
    const int c = lane & 7;
#pragma unroll
    for (int j = 0; j < 4; ++j) { const int n = (lane >> 3) + 8 * j; const LAS float* s = scr + (8 * c) * 33 + n;
        u32x4 o; o.x = cvt_pk_bf16(s[0 * 33], s[1 * 33]); o.y = cvt_pk_bf16(s[2 * 33], s[3 * 33]); o.z = cvt_pk_bf16(s[4 * 33], s[5 * 33]); o.w = cvt_pk_bf16(s[6 * 33], s[7 * 33]);
        *(GAS u32x4*)((GAS bf16_t*)WT + (size_t)(drow0 + n) * ldt + dk0 + 8 * c) = o; }
    asm volatile("s_waitcnt lgkmcnt(0)" ::: "memory");
}

__device__ __forceinline__ void prep_dft(const Params& P, LAS unsigned char* lds, int bid, int G) {
    int tid = threadIdx.x; asm volatile("" : "+v"(tid));
    unsigned char* ws = P.ws;
    LAS unsigned short* tabc = (LAS unsigned short*)(lds + 131072);
    LAS unsigned short* tabs = tabc + 4096;
    for (int i = tid; i < 4096; i += 512) { float s, c; sincospif((float)i * (1.0f / 2048.0f), &s, &c); tabc[i] = (unsigned short)f2bf(c); tabs[i] = (unsigned short)f2bf(s); }
    __syncthreads();
    { bf16_t* DFTM = (bf16_t*)(ws + OFF_DFTM);
      for (int rr = bid; rr < 4096; rr += G) { const int r = ((rr >> 11) << 12) + (rr & 2047); const int k = r & 4095;   const LAS unsigned short* tb = (r >> 12) ? tabs : tabc; const int n0 = tid * 8; unsigned e[8];
#pragma unroll
          for (int j = 0; j < 8; ++j) e[j] = tb[(k * (n0 + j)) & 4095];
          u32x4 o; o.x = e[0] | (e[1] << 16); o.y = e[2] | (e[3] << 16); o.z = e[4] | (e[5] << 16); o.w = e[6] | (e[7] << 16);
          *(GAS u32x4*)((GAS bf16_t*)DFTM + (size_t)r * 4096 + n0) = o; }
      bf16_t* DFTMC = (bf16_t*)(ws + OFF_DFTMC);
      for (int it = bid; it < 32; it += G) { const int r = it * 16 + (tid >> 5), n0 = (tid & 31) * 8, k = r & 255; const LAS unsigned short* tb = (r >> 8) ? tabs : tabc; unsigned e[8];
#pragma unroll
          for (int j = 0; j < 8; ++j) e[j] = tb[((k * (n0 + j)) & 255) << 4];
          u32x4 o; o.x = e[0] | (e[1] << 16); o.y = e[2] | (e[3] << 16); o.z = e[4] | (e[5] << 16); o.w = e[6] | (e[7] << 16);
          *(GAS u32x4*)((GAS bf16_t*)DFTMC + (size_t)r * 256 + n0) = o; } }
    __syncthreads();
}
__device__ __forceinline__ void prep_weights(const Params& P, LAS unsigned char* lds, int lay, int bid, int G, int sel) {
    int tid = threadIdx.x; asm volatile("" : "+v"(tid)); const int lane = tid & 63, wave = tid >> 6;
    unsigned char* ws = P.ws;
    LAS float* tab64 = (LAS float*)(lds + 131072 + 16384);
    if (tid < 64) tab64[tid] = cospif((float)tid * (1.0f / 32.0f));
    __syncthreads();
    { LAS float* scr = (LAS float*)(lds + wave * 16384);
      const int gw = bid * 8 + wave, NGW = G * 8;
      constexpr int I_GU = 16 * 176, I_DN = 44 * 32, I_IN = 16 * 56, I_OUT = 12 * 32;
      constexpr int NIT = 2 * I_GU + 2 * I_DN + I_IN + I_OUT;
      for (int it = gw; it < NIT; it += NGW) { int r = it;
          if (r < 2 * I_GU) { if (!((sel >> (r / I_GU)) & 1)) continue; const int mat = lay * 2 + r / I_GU, ii = r % I_GU, kb = ii / 176, nb = ii % 176, n0 = nb * 32;
              const int drow = n0 < DFF ? (n0 >> 7) * 256 + (n0 & 127) : ((n0 - DFF) >> 7) * 256 + 128 + ((n0 - DFF) & 127);
              transpose_item(P.w_gu + (size_t)mat * 1024 * 5632, 5632, kb * 64, n0, (bf16_t*)(ws + OFF_WGU + mat * SZ_WGU1), 1024, drow, kb * 64, scr, lane); continue; }
          r -= 2 * I_GU;
          if (r < 2 * I_DN) { if (!((sel >> (2 + r / I_DN)) & 1)) continue; const int mat = lay * 2 + r / I_DN, ii = r % I_DN, kb = ii / 32, nb = ii % 32;
              transpose_item(P.w_down + (size_t)mat * DFF * 1024, 1024, kb * 64, nb * 32, (bf16_t*)(ws + OFF_WDN + mat * SZ_WDN1), DFF, nb * 32, kb * 64, scr, lane); continue; }
          r -= 2 * I_DN;
          if (r < I_IN) { if (!(sel & 16)) continue; const int mat = lay, kb = r / 56, nb = r % 56;
              transpose_item(P.w_in + (size_t)mat * 1024 * 1792, 1792, kb * 64, nb * 32, (bf16_t*)(ws + OFF_WIN + mat * SZ_WIN1), 1024, nb * 32, kb * 64, scr, lane); continue; }
          r -= I_IN;
          if (sel & 32) { const int mat = lay, kb = r / 32, nb = r % 32;
              transpose_item(P.w_out + (size_t)mat * 1024 * 1024, 1024, kb * 64, nb * 32, (bf16_t*)(ws + OFF_WOUT + mat * SZ_WOUT1), 1280, nb * 32, kb * 64, scr, lane); } } }
    { const int gt = bid * 512 + tid, NGT = G * 512; const int l = lay;
      for (int idx = gt; idx < ((sel & 32) ? 256 * 1024 : 0); idx += NGT) { const int n = idx & 1023, gj = (idx >> 10) & 255, g = gj >> 6, j = gj & 63;
          const float* wp = P.w_out + (size_t)l * 1024 * 1024 + (size_t)(768 + g * 64) * 1024 + n; float cs = 0.f, sn = 0.f;
#pragma unroll 1
          for (int m0 = 0; m0 < 64; m0 += 32) { float wv[32];
#pragma unroll
              for (int m = 0; m < 32; ++m) wv[m] = wp[(size_t)(m0 + m) * 1024];
#pragma unroll
              for (int m = 0; m < 32; ++m) { const int t = ((m0 + m) * j) & 63; cs += tab64[t] * wv[m]; sn += tab64[(t + 48) & 63] * wv[m]; } }
          bf16_t* o = (bf16_t*)(ws + OFF_WOUT + l * SZ_WOUT1) + (size_t)n * 1280; o[768 + gj] = (bf16_t)f2bf(cs); o[1024 + gj] = (bf16_t)f2bf(-sn); }
      for (int i0 = gt; i0 < ((sel & 64) ? 131072 : 0); i0 += NGT) { const int idx = l * 131072 + i0; const int i = idx & 63, j = (idx >> 6) & 63, hi = idx >> 12;
          ((bf16_t*)(ws + OFF_WGT))[idx] = (bf16_t)f2bf(P.lru_wg[(size_t)hi * 4096 + i * 64 + j]); }
      for (int i0 = gt; i0 < ((sel & 64) ? 65536 : 0); i0 += NGT) { const int idx = l * 65536 + i0; ((bf16_t*)(ws + OFF_GWS))[idx] = (bf16_t)f2bf(P.gmlp_ws[idx]); } }
    __syncthreads();
}
__device__ __forceinline__ void phase_prep(const Params& P, LAS unsigned char* lds) {
    int tid = threadIdx.x; asm volatile("" : "+v"(tid)); const int lane = tid & 63, wave = tid >> 6, G = gridDim.x, bid = blockIdx.x;
    unsigned char* ws = P.ws;
    prep_weights(P, lds, 0, bid, G, 1 | 4);
    { const int gt = bid * 512 + tid, NGT = G * 512;
      for (int idx = gt; idx < 2048; idx += NGT) ((float*)(ws + OFF_SP8))[idx] = 8.0f * log1pf(expf(-P.lru_lam[idx])); }
    __syncthreads();
    { LAS float* sc = (LAS float*)lds;
      LAS float* red = (LAS float*)(lds + 36864);
      for (int i = tid; i < 9 * 1024; i += 512) { const int v = i >> 10, k = i & 1023; const float cv = v < 8 ? P.c[v * 1024 + k] : P.c_ctx[k]; sc[i] = cv / (1.0f + expf(-cv)); }
      __syncthreads();
      float* MOD = (float*)(ws + OFF_MOD);
      for (int it = bid; it < 288; it += G) { const int l = it / 144, col0 = (it % 144) * 64, kc = tid >> 4, cq = tid & 15;
          f32x4 a[9];
#pragma unroll
          for (int v = 0; v < 9; ++v) a[v] = (f32x4){0.f, 0.f, 0.f, 0.f};
          const float* wp = P.w_mod + (size_t)l * 1024 * 9216 + (size_t)(kc * 32) * 9216 + col0 + 4 * cq;
#pragma unroll 1
          for (int k0 = 0; k0 < 32; k0 += 16) { f32x4 wv[16];
#pragma unroll
              for (int k = 0; k < 16; ++k) wv[k] = *(const f32x4*)(wp + (size_t)(k0 + k) * 9216);
#pragma unroll
              for (int k = 0; k < 16; ++k) {
#pragma unroll
                  for (int v = 0; v < 9; ++v) a[v] += wv[k] * sc[v * 1024 + kc * 32 + k0 + k]; } }
#pragma unroll
          for (int v = 0; v < 9; ++v) *(LAS f32x4*)(red + (kc * 9 + v) * 64 + 4 * cq) = a[v];
          __syncthreads();
          for (int o = tid; o < 9 * 64; o += 512) { const int v = o >> 6, cc = o & 63; float s = P.b_mod[l * 9216 + col0 + cc];
#pragma unroll
              for (int q = 0; q < 32; ++q) s += red[(q * 9 + v) * 64 + cc];
              MOD[(size_t)(l * 9 + v) * 9216 + col0 + cc] = s; }
          __syncthreads(); } }
}

__device__ __forceinline__ void norm_store(const f32x4 (&v)[4], const float* modv, int shift_k, int scale_k, const float* g, bf16_t* xnrow, int lane) {
    float ss = 0.f;
#pragma unroll
    for (int j = 0; j < 4; ++j) ss += (v[j].x * v[j].x + v[j].y * v[j].y) + (v[j].z * v[j].z + v[j].w * v[j].w);
    const float rstd = 1.0f / sqrtf(wave_sum(ss) * (1.0f / 1024.0f) + 1e-6f);
#pragma unroll
    for (int j = 0; j < 4; ++j) { const int c0 = 4 * lane + 256 * j;
        const f32x4 gg = *(const f32x4*)(g + c0), sc = *(const f32x4*)(modv + scale_k * 1024 + c0), sh = *(const f32x4*)(modv + shift_k * 1024 + c0);
        const f32x4 y = v[j] * rstd * gg * (sc + 1.0f) + sh;
        u32x2 w; w.x = cvt_pk_bf16(y.x, y.y); w.y = cvt_pk_bf16(y.z, y.w); *(GAS u32x2*)((GAS bf16_t*)xnrow + c0) = w; }
}
__device__ __forceinline__ void phase_init(const Params& P) {
    int tid = threadIdx.x; asm volatile("" : "+v"(tid)); const int lane = tid & 63, wave = tid >> 6, gw = blockIdx.x * 8 + wave, NGW = gridDim.x * 8;
    float* Hc = (float*)(P.ws + OFF_HC); bf16_t* XN = (bf16_t*)(P.ws + OFF_XN); const float* MOD = (const float*)(P.ws + OFF_MOD);
    float fr4[4];
#pragma unroll
    for (int e = 0; e < 4; ++e) fr4[e] = 1.0f / powf(10000.0f, (float)(4 * lane + e) * (1.0f / 256.0f));
    const int sA = gw & 4095, sB = (gw + NGW) & 4095; f32x4 posA[4], posB[4];
#pragma unroll
    for (int e = 0; e < 4; ++e) { float s1, c1, s2, c2;
        sincosf((float)(sA >> 6) * fr4[e], &s1, &c1); sincosf((float)(sA & 63) * fr4[e], &s2, &c2); posA[0][e] = s1; posA[1][e] = c1; posA[2][e] = s2; posA[3][e] = c2;
        sincosf((float)(sB >> 6) * fr4[e], &s1, &c1); sincosf((float)(sB & 63) * fr4[e], &s2, &c2); posB[0][e] = s1; posB[1][e] = c1; posB[2][e] = s2; posB[3][e] = c2; }
#define IN_LOAD(R, V, SC, SH) do { const int _r = (R); const float* _xr = _r < TL ? P.x + (size_t)_r * 1024 : P.ctx + (size_t)(_r - TL) * 1024; const float* _mv = MOD + (size_t)(_r < TL ? (_r >> 12) : 8) * 9216; \
        _Pragma("unroll") for (int j = 0; j < 4; ++j) { const int c0 = 4 * lane + 256 * j; V[j] = *(const f32x4*)(_xr + c0); SC[j] = *(const f32x4*)(_mv + 1024 + c0); SH[j] = *(const f32x4*)(_mv + c0); } } while (0)
    f32x4 gg[4], v[4], sc[4], sh[4];
#pragma unroll
    for (int j = 0; j < 4; ++j) gg[j] = *(const f32x4*)(P.norm_g + 4 * lane + 256 * j);
    if (gw < T) IN_LOAD(gw, v, sc, sh);
    for (int r = gw; r < T; r += NGW) { const int rn = r + NGW; f32x4 vn[4], scn[4], shn[4];
        if (rn < T) IN_LOAD(rn, vn, scn, shn);
        __builtin_amdgcn_sched_barrier(0);
        float* hr;
        if (r < TL) { const int s = r & 4095;
            if (s == sA) {
#pragma unroll
                for (int j = 0; j < 4; ++j) v[j] += posA[j];
            } else if (s == sB) {
#pragma unroll
                for (int j = 0; j < 4; ++j) v[j] += posB[j];
            } else { const float rr = (float)(s >> 6), cc = (float)(s & 63);
#pragma unroll
                for (int e = 0; e < 4; ++e) { float s1, c1, s2, c2; sincosf(rr * fr4[e], &s1, &c1); sincosf(cc * fr4[e], &s2, &c2); v[0][e] += s1; v[1][e] += c1; v[2][e] += s2; v[3][e] += c2; }
            }
            hr = P.out + (size_t)r * 1024; }
        else hr = Hc + (size_t)(r - TL) * 1024;
        float ss = 0.f;
#pragma unroll
        for (int j = 0; j < 4; ++j) { *(f32x4*)(hr + 4 * lane + 256 * j) = v[j]; ss += (v[j].x * v[j].x + v[j].y * v[j].y) + (v[j].z * v[j].z + v[j].w * v[j].w); }
        const float rstd = 1.0f / sqrtf(wave_sum(ss) * (1.0f / 1024.0f) + 1e-6f);
#pragma unroll
        for (int j = 0; j < 4; ++j) { const f32x4 y = v[j] * rstd * gg[j] * (sc[j] + 1.0f) + sh[j];
            u32x2 w; w.x = cvt_pk_bf16(y.x, y.y); w.y = cvt_pk_bf16(y.z, y.w); *(GAS u32x2*)((GAS bf16_t*)XN + (size_t)r * 1024 + 4 * lane + 256 * j) = w; }
        if (rn < T) {
#pragma unroll
            for (int j = 0; j < 4; ++j) { v[j] = vn[j]; sc[j] = scn[j]; sh[j] = shn[j]; } }
    }
#undef IN_LOAD
}
#define NR_LOAD(R, V, SC, SH) do { const int _r = (R); const float* _hr = _r < TL ? P.out + (size_t)_r * 1024 : Hc + (size_t)(_r - TL) * 1024; const float* _mv = MOD + (size_t)(_r < TL ? (_r >> 12) : 8) * 9216; \
        _Pragma("unroll") for (int j = 0; j < 4; ++j) { const int c0 = 4 * lane + 256 * j; V[j] = *(const f32x4*)(_hr + c0); SC[j] = *(const f32x4*)(_mv + (3 * sub + 1) * 1024 + c0); SH[j] = *(const f32x4*)(_mv + (3 * sub) * 1024 + c0); } \
        if (addpart && _r >= TL) { const size_t _o = (size_t)(_r - TL) * 1024; const float* _pr = (const float*)(P.ws + OFF_PART) + _o; _Pragma("unroll") for (int j = 0; j < 4; ++j) V[j] += *(const f32x4*)(_pr + 4 * lane + 256 * j); \
            if (addpart > 1) { const float* _p2 = (const float*)(P.ws + OFF_PART2) + _o; const float* _p3 = (const float*)(P.ws + OFF_PART3) + _o; _Pragma("unroll") for (int j = 0; j < 4; ++j) V[j] += *(const f32x4*)(_p2 + 4 * lane + 256 * j) + *(const f32x4*)(_p3 + 4 * lane + 256 * j); } } } while (0)
__device__ __forceinline__ void phase_norm(const Params& P, int l, int sub, int addpart) {
    int tid = threadIdx.x; asm volatile("" : "+v"(tid)); const int lane = tid & 63, wave = tid >> 6; const int rbeg = blockIdx.x * 8 + wave, rstride = gridDim.x * 8, rend = T;
    const float* Hc = (const float*)(P.ws + OFF_HC); bf16_t* XN = (bf16_t*)(P.ws + OFF_XN); const float* MOD = (const float*)(P.ws + OFF_MOD) + (size_t)l * 9 * 9216;
    const float* g = P.norm_g + (l * 3 + sub) * 1024; f32x4 gg[4];
#pragma unroll
    for (int j = 0; j < 4; ++j) gg[j] = *(const f32x4*)(g + 4 * lane + 256 * j);
    f32x4 v[4], sc[4], sh[4];
    if (rbeg < rend) NR_LOAD(rbeg, v, sc, sh);
    for (int r = rbeg; r < rend; r += rstride) { const int rn = r + rstride; f32x4 vn[4], scn[4], shn[4];
        if (rn < rend) NR_LOAD(rn, vn, scn, shn);
        __builtin_amdgcn_sched_barrier(0);
        if (addpart && r >= TL) { float* hw = (float*)(P.ws + OFF_HC) + (size_t)(r - TL) * 1024;
#pragma unroll
            for (int j = 0; j < 4; ++j) *(f32x4*)(hw + 4 * lane + 256 * j) = v[j]; }
        float ss = 0.f;
#pragma unroll
        for (int j = 0; j < 4; ++j) ss += (v[j].x * v[j].x + v[j].y * v[j].y) + (v[j].z * v[j].z + v[j].w * v[j].w);
        const float rstd = 1.0f / sqrtf(wave_sum(ss) * (1.0f / 1024.0f) + 1e-6f);
#pragma unroll
        for (int j = 0; j < 4; ++j) { const f32x4 y = v[j] * rstd * gg[j] * (sc[j] + 1.0f) + sh[j];
            u32x2 w; w.x = cvt_pk_bf16(y.x, y.y); w.y = cvt_pk_bf16(y.z, y.w); *(GAS u32x2*)((GAS bf16_t*)XN + (size_t)r * 1024 + 4 * lane + 256 * j) = w; }
        if (rn < rend) {
#pragma unroll
            for (int j = 0; j < 4; ++j) { v[j] = vn[j]; sc[j] = scn[j]; sh[j] = shn[j]; } }
    }
}
#undef NR_LOAD
__device__ __forceinline__ void phase_final(const Params& P) {
    int tid = threadIdx.x; asm volatile("" : "+v"(tid)); const int lane = tid & 63, wave = tid >> 6, gw = blockIdx.x * 8 + wave, NGW = gridDim.x * 8;
    f32x4 gg[4], v[4];
#pragma unroll
    for (int j = 0; j < 4; ++j) gg[j] = *(const f32x4*)(P.final_g + 4 * lane + 256 * j);
    if (gw < TL) {
#pragma unroll
        for (int j = 0; j < 4; ++j) v[j] = *(const f32x4*)(P.out + (size_t)gw * 1024 + 4 * lane + 256 * j); }
    for (int r = gw; r < TL; r += NGW) { float* hr = P.out + (size_t)r * 1024; const int rn = r + NGW; f32x4 vn[4];
        if (rn < TL) {
#pragma unroll
            for (int j = 0; j < 4; ++j) vn[j] = *(const f32x4*)(P.out + (size_t)rn * 1024 + 4 * lane + 256 * j); }
        __builtin_amdgcn_sched_barrier(0);
        float ss = 0.f;
#pragma unroll
        for (int j = 0; j < 4; ++j) ss += (v[j].x * v[j].x + v[j].y * v[j].y) + (v[j].z * v[j].z + v[j].w * v[j].w);
        const float rstd = 1.0f / sqrtf(wave_sum(ss) * (1.0f / 1024.0f) + 1e-6f);
#pragma unroll
        for (int j = 0; j < 4; ++j) *(f32x4*)(hr + 4 * lane + 256 * j) = v[j] * rstd * gg[j];
        if (rn < TL) {
#pragma unroll
            for (int j = 0; j < 4; ++j) v[j] = vn[j]; } }
}

__device__ __forceinline__ int queue_pull(unsigned* q, int lane) { unsigned nx = 0; if (lane == 0) nx = __hip_atomic_fetch_add(q, 1u, __ATOMIC_RELAXED, __HIP_MEMORY_SCOPE_AGENT); return 256 + (int)__builtin_amdgcn_readfirstlane(nx); }
__device__ __forceinline__ void gmlp_items(const Params& P, int l, int local, unsigned* q) {
    int tid = threadIdx.x; asm volatile("" : "+v"(tid)); const int lane = tid & 63, wslot = tid >> 6, fr = lane & 15, fq = lane >> 4;
    const GAS bf16_t* GWS = (const GAS bf16_t*)(P.ws + OFF_GWS + l * SZ_GWS1); const GAS bf16_t* Z = (const GAS bf16_t*)(P.ws + OFF_Z); GAS bf16_t* Y = (GAS bf16_t*)(P.ws + OFF_Y);
    const int xq = blockIdx.x & 7;
    for (; local < 680; local = queue_pull(q, lane)) { const int it = xq * 136 + (local - 544); const int ch = it >> 2, g = it & 3; const GAS bf16_t* VTb; int ldv;
        if (ch < 256) { const int b = ch >> 5, n0 = (ch & 31) * 128; VTb = (const GAS bf16_t*)(P.ws + OFF_VT) + ((size_t)b * 256 + g * 64) * 4096 + n0; ldv = 4096; }
        else { const int cc = ch - 256, b = cc >> 1, n0 = (cc & 1) * 128; VTb = (const GAS bf16_t*)(P.ws + OFF_VTC) + ((size_t)b * 256 + g * 64) * 256 + n0; ldv = 256; }
        bf16x8 Afv[4][4];
#pragma unroll
        for (int kk = 0; kk < 4; ++kk)
#pragma unroll
            for (int mt = 0; mt < 4; ++mt) Afv[kk][mt] = *(const GAS bf16x8*)(VTb + (size_t)(mt * 16 + fr) * ldv + kk * 32 + 8 * fq);
#pragma unroll 1
        for (int half = 0; half < 2; ++half) {
            bf16x8 Bfv[4][4]; u32x2 uua[4][4]; float bsv[4];
#pragma unroll
            for (int q = 0; q < 4; ++q) { const int p = 16 * (4 * half + q) + fr; const size_t row = (size_t)ch * 128 + p; bsv[q] = P.gmlp_bs[(l * 4 + g) * 128 + p];
#pragma unroll
                for (int kk = 0; kk < 4; ++kk) Bfv[q][kk] = *(const GAS bf16x8*)(GWS + ((size_t)(g * 128 + p)) * 128 + kk * 32 + 8 * fq);
#pragma unroll
                for (int mt = 0; mt < 4; ++mt) uua[q][mt] = *(const GAS u32x2*)(Z + row * ZW + 1024 + g * 64 + mt * 16 + 4 * fq); }
            __builtin_amdgcn_sched_barrier(0);
#pragma unroll
            for (int q = 0; q < 4; ++q) { const int p = 16 * (4 * half + q) + fr; const size_t row = (size_t)ch * 128 + p;
                f32x4 acc[4];
#pragma unroll
                for (int mt = 0; mt < 4; ++mt) acc[mt] = (f32x4){0.f, 0.f, 0.f, 0.f};
#pragma unroll
                for (int kk = 0; kk < 4; ++kk)
#pragma unroll
                    for (int mt = 0; mt < 4; ++mt) acc[mt] = __builtin_amdgcn_mfma_f32_16x16x32_bf16(Afv[kk][mt], Bfv[q][kk], acc[mt], 0, 0, 0);
#pragma unroll
                for (int mt = 0; mt < 4; ++mt) { const int d0 = mt * 16 + 4 * fq; const u32x2 uu = uua[q][mt];
                    const float u0 = __uint_as_float(uu.x << 16), u1 = __uint_as_float(uu.x & 0xffff0000u), u2 = __uint_as_float(uu.y << 16), u3 = __uint_as_float(uu.y & 0xffff0000u);
                    u32x2 o; o.x = cvt_pk_bf16(u0 * (acc[mt][0] + bsv[q]), u1 * (acc[mt][1] + bsv[q])); o.y = cvt_pk_bf16(u2 * (acc[mt][2] + bsv[q]), u3 * (acc[mt][3] + bsv[q]));
                    *(GAS u32x2*)(Y + row * YW + 512 + g * 64 + d0) = o; } }
        }
    }
}

__device__ __forceinline__ void dft_nyquist(const Params& P) {
    int tid = threadIdx.x; asm volatile("" : "+v"(tid)); const int lane = tid & 63;
    const GAS bf16_t* FT = (const GAS bf16_t*)(P.ws + OFF_FT); GAS bf16_t* Y = (GAS bf16_t*)(P.ws + OFF_Y);
    for (int wi = blockIdx.x * 8 + (tid >> 6); wi < NB * 256; wi += gridDim.x * 8) { const int b = wi >> 8, ch = wi & 255; const GAS bf16_t* fp = FT + ((size_t)b * 256 + ch) * 4096; float a = 0.f;
        u32x4 qv[8];
#pragma unroll
        for (int j = 0; j < 8; ++j) qv[j] = *(const GAS u32x4*)(fp + (size_t)(j * 64 + lane) * 8);
        __builtin_amdgcn_sched_barrier(0);
#pragma unroll
        for (int j = 0; j < 8; ++j) {
#pragma unroll
            for (int e = 0; e < 4; ++e) a += __uint_as_float(qv[j][e] << 16) - __uint_as_float(qv[j][e] & 0xffff0000u); }
        a = wave_sum(a);
        if (lane == 0) { GAS bf16_t* yr = Y + (size_t)(b * 4096 + 2048) * YW; yr[768 + ch] = (bf16_t)f2bf(a * (1.0f / 512.0f)); yr[1024 + ch] = (bf16_t)0; } }
}

__device__ __forceinline__ int lru_pass1(const Params& P, int l, LAS unsigned char* lds, unsigned* qw) {
    int tid = threadIdx.x; asm volatile("" : "+v"(tid)); const int lane = tid & 63, fr = lane & 15, fq = lane >> 4;
    const GAS bf16_t* Z = (const GAS bf16_t*)(P.ws + OFF_Z);
    const GAS bf16_t* WGT = (const GAS bf16_t*)(P.ws + OFF_WGT + l * SZ_WGT1); GAS float* AGG = (GAS float*)(P.ws + OFF_AGG); GAS unsigned* AB = (GAS unsigned*)(P.ws + OFF_AB);
    LAS unsigned short* xcS = (LAS unsigned short*)(lds + (tid >> 6) * 9216);
    LAS unsigned short* xaS = (LAS unsigned short*)(lds + 8 * 9216 + (tid >> 6) * 8704);
    const GAS float* SP8 = (const GAS float*)(P.ws + OFF_SP8);
    const int wslot = tid >> 6;
    const int xq = blockIdx.x & 7, jq = blockIdx.x >> 3;
    int local = jq >= 16 ? (jq - 16) * 8 + wslot : 128 + jq * 8 + wslot;
    for (;;) {
        if (local >= 544) break;
        const int wi = xq * 544 + local;
        const int it = wi >> 3, h = wi & 7;
        int b, j, q, Ls, r0seq;
        if (it < 512) { b = it >> 6; j = it & 63; q = 4 + j; Ls = 4096; r0seq = b * 4096; } else { const int t2 = it - 512; b = t2 >> 2; j = t2 & 3; q = j; Ls = 256; r0seq = TL + b * 256; }
        const int n0 = j * 64, r0 = r0seq + n0;
        {
            u32x4 tq[9];
#pragma unroll
            for (int jq = 0; jq < 9; ++jq) { const int qi = lane + 64 * jq, row = min(qi >> 3, 66), ch8 = qi & 7; const int n = n0 - 2 + row, nn = min(max(n, 0), Ls - 1);
                tq[jq] = *(const GAS u32x4*)(Z + (size_t)(r0seq + nn) * ZW + h * 64 + ch8 * 8); }
            __builtin_amdgcn_sched_barrier(0);
#pragma unroll
            for (int jq = 0; jq < 9; ++jq) { const int qi = lane + 64 * jq, row = qi >> 3, ch8 = qi & 7; if (row < 67) *(LAS u32x4*)(xaS + row * 64 + ch8 * 8) = tq[jq]; }
            asm volatile("s_waitcnt lgkmcnt(0)" ::: "memory");
            const int c = h * 64 + lane; const float* cw = P.conv_w + l * 4 * 512 + c; const float w0 = cw[0], w1 = cw[512], w2 = cw[1024], w3 = cw[1536], cb = P.conv_b[l * 512 + c];
            float xv[67];
#pragma unroll
            for (int i = 0; i < 67; ++i) { const int n = n0 - 2 + i; xv[i] = bf2f(xaS[i * 64 + lane]) * ((n >= 0 && n < Ls) ? 1.0f : 0.0f); }
#pragma unroll
            for (int p = 0; p < 64; ++p) { const float xc = cb + w0 * xv[p] + w1 * xv[p + 1] + w2 * xv[p + 2] + w3 * xv[p + 3]; xcS[p * 72 + lane] = (unsigned short)f2bf(xc); }
        }
        asm volatile("s_waitcnt lgkmcnt(0)" ::: "memory");
        bf16x8 Af[4][2];
#pragma unroll
        for (int mt = 0; mt < 4; ++mt)
#pragma unroll
            for (int kk = 0; kk < 2; ++kk) { const int row = 16 * (fr >> 2) + 4 * mt + (fr & 3); Af[mt][kk] = *(const LAS bf16x8*)(xcS + row * 72 + kk * 32 + 8 * fq); }
#pragma unroll 1
        for (int jt = 0; jt < 4; ++jt) { const int cl = 16 * jt + fr, c = h * 64 + cl;
            f32x4 acc[4][4];
#pragma unroll
            for (int mt = 0; mt < 4; ++mt)
#pragma unroll
                for (int dt = 0; dt < 4; ++dt) acc[mt][dt] = (f32x4){0.f, 0.f, 0.f, 0.f};
            bf16x8 Bfr[4][2];
#pragma unroll
            for (int dt = 0; dt < 4; ++dt)
#pragma unroll
                for (int kk = 0; kk < 2; ++kk) Bfr[dt][kk] = *(const GAS bf16x8*)(WGT + ((size_t)((dt * 8 + h) * 64 + cl)) * 64 + kk * 32 + 8 * fq);
            __builtin_amdgcn_sched_barrier(0);
#pragma unroll
            for (int dt = 0; dt < 4; ++dt)
#pragma unroll
                for (int kk = 0; kk < 2; ++kk) {
#pragma unroll
                    for (int mt = 0; mt < 4; ++mt) acc[mt][dt] = __builtin_amdgcn_mfma_f32_16x16x32_bf16(Af[mt][kk], Bfr[dt][kk], acc[mt][dt], 0, 0, 0); }
            u32x2 abw[16];
#pragma unroll
            for (int d = 0; d < 2; ++d) {
                const float bgr = P.lru_bg[((l * 2 + d) * 2 + 0) * 512 + c], bgi = P.lru_bg[((l * 2 + d) * 2 + 1) * 512 + c];
                const float sp8 = SP8[(l * 2 + d) * 512 + c];
#pragma unroll
                for (int mt = 0; mt < 4; ++mt)
#pragma unroll
                    for (int ip = 0; ip < 2; ++ip) { const int p = 16 * fq + 4 * mt + 2 * ip;
                        const f32x2 xcv = (f32x2){bf2f(xcS[p * 72 + cl]), bf2f(xcS[(p + 1) * 72 + cl])};
                        const f32x2 tr = ((f32x2){acc[mt][2 * d][2 * ip], acc[mt][2 * d][2 * ip + 1]} + bgr) * (-1.4426950408889634f);
                        const f32x2 ti = ((f32x2){acc[mt][2 * d + 1][2 * ip], acc[mt][2 * d + 1][2 * ip + 1]} + bgi) * (-1.4426950408889634f);
                        const f32x2 dr = (f32x2){__builtin_amdgcn_exp2f(tr.x), __builtin_amdgcn_exp2f(tr.y)} + 1.0f, di = (f32x2){__builtin_amdgcn_exp2f(ti.x), __builtin_amdgcn_exp2f(ti.y)} + 1.0f;
                        const f32x2 r = (f32x2){__builtin_amdgcn_rcpf(dr.x), __builtin_amdgcn_rcpf(dr.y)}, ig = (f32x2){__builtin_amdgcn_rcpf(di.x), __builtin_amdgcn_rcpf(di.y)};
                        const f32x2 la = r * (-sp8), x2 = la + la;
                        f32x2 q5 = x2 * 0.0083333333f + 0.041666668f; q5 = q5 * x2 + 0.16666667f; q5 = q5 * x2 + 0.5f; q5 = q5 * x2 + 1.0f; f32x2 em = -(x2 * q5);
                        if (__builtin_expect(__any((x2.x < -0.25f) || (x2.y < -0.25f)), 0)) {
                            if (x2.x < -0.25f) em.x = 1.0f - __expf(x2.x);
                            if (x2.y < -0.25f) em.y = 1.0f - __expf(x2.y); }
                        const f32x2 tl = la * 1.4426950408889634f; const f32x2 om = 1.0f - (f32x2){__builtin_amdgcn_exp2f(tl.x), __builtin_amdgcn_exp2f(tl.y)};
                        const f32x2 bvv = (f32x2){__builtin_amdgcn_sqrtf(em.x), __builtin_amdgcn_sqrtf(em.y)} * ig * xcv;
                        const unsigned wq0 = cvt_pk_bf16(om.x, bvv.x), wq1 = cvt_pk_bf16(om.y, bvv.y);
                        acc[mt][2 * d][2 * ip] = 1.0f - __uint_as_float(wq0 << 16); acc[mt][2 * d + 1][2 * ip] = __uint_as_float(wq0 & 0xffff0000u);
                        acc[mt][2 * d][2 * ip + 1] = 1.0f - __uint_as_float(wq1 << 16); acc[mt][2 * d + 1][2 * ip + 1] = __uint_as_float(wq1 & 0xffff0000u);
                        abw[mt * 4 + 2 * ip][d] = wq0; abw[mt * 4 + 2 * ip + 1][d] = wq1; }
                float Ar = 1.f, Br = 0.f;
#pragma unroll
                for (int s = 0; s < 16; ++s) { const int idx = d == 0 ? s : 15 - s; const float a = acc[idx >> 2][2 * d][idx & 3], bb = acc[idx >> 2][2 * d + 1][idx & 3]; Br = a * Br + bb; Ar *= a; }
                float Ac = 1.f, Bc = 0.f;
#pragma unroll
                for (int s = 0; s < 4; ++s) { const int f = d == 0 ? s : 3 - s; const float af = __shfl(Ar, fr + 16 * f), bf = __shfl(Br, fr + 16 * f); Bc = af * Bc + bf; Ac *= af; }
                if (fq == 0) { GAS float* ap = AGG + ((size_t)((b * NQ + q) * 2 + d) * 2) * 512 + c; ap[0] = Ac; ap[512] = Bc; }
            }
#pragma unroll
            for (int idx = 0; idx < 16; ++idx) *(GAS u32x2*)(AB + ((size_t)(r0 + 16 * fq + idx) * 512 + c) * 2) = abw[idx];
        }
        asm volatile("s_waitcnt lgkmcnt(0)" ::: "memory");
        local = queue_pull(qw, lane);
    }
    return local;
}
__device__ __forceinline__ void lru_scan(const Params& P, int l) {
    int tid = threadIdx.x; asm volatile("" : "+v"(tid)); const int c = tid;
    const GAS bf16_t* Z = (const GAS bf16_t*)(P.ws + OFF_Z); GAS bf16_t* Y = (GAS bf16_t*)(P.ws + OFF_Y);
    const GAS float* AGG = (const GAS float*)(P.ws + OFF_AGG); const GAS unsigned* AB = (const GAS unsigned*)(P.ws + OFF_AB);
    const int nitems = (l == 1) ? 512 : 544;
    for (int it = blockIdx.x; it < nitems; it += gridDim.x) {
        int b, j, q, r0seq;
        if (it < 512) { b = it >> 6; j = it & 63; q = 4 + j; r0seq = b * 4096; } else { const int t2 = it - 512; b = t2 >> 2; j = t2 & 3; q = j; r0seq = TL + b * 256; }
        const int r0 = r0seq + j * 64;
        float hin[2];
#pragma unroll
        for (int d = 0; d < 2; ++d) { const int rank = d == 0 ? q : (q < 4 ? 3 - q : 71 - q); float hh = 0.f;
#pragma unroll 1
            for (int r8 = 0; r8 < rank; r8 += 34) { float aa[34], bv[34];
#pragma unroll
                for (int k = 0; k < 34; ++k) { const int rho = r8 + k; const bool ok = rho < rank; const int rr = ok ? rho : 0; const int qq = d == 0 ? rr : (rr < 4 ? 3 - rr : 71 - rr);
                    const GAS float* ap = AGG + ((size_t)((b * NQ + qq) * 2 + d) * 2) * 512 + c; const float a0 = ap[0], b0 = ap[512]; aa[k] = ok ? a0 : 1.f; bv[k] = ok ? b0 : 0.f; }
#pragma unroll
                for (int k = 0; k < 34; ++k) hh = aa[k] * hh + bv[k]; }
            hin[d] = hh; }
        const GAS u32x2* abp = (const GAS u32x2*)(AB + ((size_t)r0 * 512 + c) * 2);
        u32x2 w[64];
#pragma unroll
        for (int p = 0; p < 64; ++p) w[p] = abp[(size_t)p * 512];
        float hf[64]; { float hh = hin[0];
#pragma unroll
            for (int p = 0; p < 64; ++p) { const float om = __uint_as_float(w[p].x << 16), bb = __uint_as_float(w[p].x & 0xffff0000u); hh = (hh - om * hh) + bb; hf[p] = hh; } }
        unsigned short gar[64];
#pragma unroll
        for (int p = 0; p < 64; ++p) gar[p] = Z[(size_t)(r0 + p) * ZW + 512 + c];
        { float hh = hin[1];
#pragma unroll
            for (int p = 63; p >= 0; --p) { const float om = __uint_as_float(w[p].y << 16), bb = __uint_as_float(w[p].y & 0xffff0000u); hh = (hh - om * hh) + bb;
                Y[(size_t)(r0 + p) * YW + c] = (bf16_t)f2bf((hf[p] + hh) * bf2f(gar[p])); } }
    }
}

#define XB_TMO      128
#define XB_XCNT(j)  (256  + 64 * (j))
#define XB_XSUB(j)  (1280 + 64 * (j))
#define XB_XGEN(j)  (2304 + 64 * (j))
#define XB_TOP      3328
#define XB_TOPGEN   3392
#define XCD_BAR_WORDS 3456
#define XB_SPIN_CAP (1u << 22)
__device__ __forceinline__ unsigned xb_ld(unsigned* p)              { return __hip_atomic_load(p, __ATOMIC_RELAXED, __HIP_MEMORY_SCOPE_AGENT); }
__device__ __forceinline__ unsigned xb_add(unsigned* p, unsigned v) { return __hip_atomic_fetch_add(p, v, __ATOMIC_RELAXED, __HIP_MEMORY_SCOPE_AGENT); }
__device__ __forceinline__ unsigned xb_xcc_id() { return (unsigned)__builtin_amdgcn_s_getreg((3 << 11) | 20) & 0xFu; }
#define XB_SPIN(cond, bar) do { unsigned _sp = 0; while (cond) { __builtin_amdgcn_s_sleep(1); \
    if ((++_sp & 255u) == 0u) { if (xb_ld(&(bar)[XB_TMO])) break; if (_sp > XB_SPIN_CAP) { atomicAdd(&(bar)[XB_TMO], 1u); break; } } } } while (0)
struct XcdBarrier { unsigned* bar; unsigned x; volatile LAS unsigned* st; };
__device__ __forceinline__ XcdBarrier xcd_barrier_post(unsigned* bar, volatile LAS unsigned* st) {
    XcdBarrier b; b.bar = bar; b.x = xb_xcc_id(); b.st = st;
    if (threadIdx.x == 0) (void)xb_add(&bar[XB_XCNT(b.x)], 1u);
    return b;
}
__device__ __forceinline__ void xcd_barrier_complete(unsigned* bar, unsigned x, unsigned& nloc, unsigned& nx) {
    const unsigned G = gridDim.x * gridDim.y * gridDim.z;
    unsigned sum, cnt, mine, sp = 0u;
    for (;;) {
        sum = 0u; cnt = 0u; mine = 0u;
#pragma unroll
        for (unsigned j = 0; j < 16; ++j) { const unsigned c = xb_ld(&bar[XB_XCNT(j)]); sum += c; cnt += (c > 0u) ? 1u : 0u; mine = (j == x) ? c : mine; }
        if (sum == G) break;
        __builtin_amdgcn_s_sleep(1);
        if ((++sp & 255u) == 0u) { if (xb_ld(&bar[XB_TMO])) break; if (sp > XB_SPIN_CAP) { atomicAdd(&bar[XB_TMO], 1u); break; } }
    }
    nloc = mine > 0u ? mine : 1u; nx = cnt > 0u ? cnt : 1u;
}
__device__ __forceinline__ void xcd_barrier(const XcdBarrier& b) {
    asm volatile("s_waitcnt vmcnt(0)" ::: "memory");
    __syncthreads();
    if (threadIdx.x == 0) {
        unsigned* bar = b.bar;
        __builtin_amdgcn_s_waitcnt(0);
        unsigned nloc = b.st[0], nx = b.st[1];
        if (nloc == 0u) { xcd_barrier_complete(bar, b.x, nloc, nx); b.st[0] = nloc; b.st[1] = nx; }
        const unsigned old = xb_add(&bar[XB_XSUB(b.x)], 1u);
        const unsigned gen = old / nloc;
        if (old + 1u == (gen + 1u) * nloc) {
            __builtin_amdgcn_fence(__ATOMIC_RELEASE, "agent");
            asm volatile("s_waitcnt vmcnt(0)" ::: "memory");
            const unsigned og = xb_add(&bar[XB_TOP], 1u);
            const unsigned tg = og / nx;
            if (og + 1u == (tg + 1u) * nx) xb_add(&bar[XB_TOPGEN], 1u);
            else XB_SPIN(xb_ld(&bar[XB_TOPGEN]) == tg, bar);
            __builtin_amdgcn_fence(__ATOMIC_ACQUIRE, "agent");
            xb_add(&bar[XB_XGEN(b.x)], 1u);
            asm volatile("s_waitcnt vmcnt(0)" ::: "memory");
        } else {
            XB_SPIN(xb_ld(&bar[XB_XGEN(b.x)]) == gen, bar);
            __builtin_amdgcn_fence(__ATOMIC_ACQUIRE, "agent");
            asm volatile("s_waitcnt vmcnt(0)" ::: "memory");
        }
    }
    __syncthreads();
}

__global__ void __launch_bounds__(512, 2) mega(Params P) {
    extern __shared__ __attribute__((aligned(16))) unsigned char lds_raw[];
    LAS unsigned char* lds = (LAS unsigned char*)lds_raw;
    cg::grid_group grid = cg::this_grid();
    unsigned char* ws = P.ws; const int G = gridDim.x, c = blockIdx.x;
    if (P.ph_lo < 0) grid.sync();
    volatile LAS unsigned* MISC = (volatile LAS unsigned*)(lds + 148480);
    if (threadIdx.x < 2) MISC[threadIdx.x] = 0u;
    __syncthreads();
    const XcdBarrier bar = xcd_barrier_post((unsigned*)(ws + OFF_BAR), MISC);
    int ph = 0;
#define RUN(...) do { if (ph >= P.ph_lo && ph < P.ph_hi) { __VA_ARGS__; if (ph + 1 < P.ph_hi) xcd_barrier(bar); } ++ph; } while (0)
    RUN(phase_prep(P, lds));
    RUN(phase_init(P));
    float* Hc = (float*)(ws + OFF_HC);
    for (int l = 0; l < 2; ++l) {
        const float* MODl = (const float*)(ws + OFF_MOD) + (size_t)l * 9 * 9216;
        for (int f = 0; f < 2; ++f) {
            if (f == 1) {
                RUN(phase_norm(P, l, 1, l == 1 ? 3 : 1));
                RUN({ InOrder S{(const char*)(ws + OFF_XN), (const char*)(ws + OFF_WIN + l * SZ_WIN1), G, c};
                      EpiIn E{(bf16_t*)(ws + OFF_Z), (bf16_t*)(ws + OFF_VT), (bf16_t*)(ws + OFF_VTC), (bf16_t*)(ws + OFF_FT), (bf16_t*)(ws + OFF_FTC)};
                      gemm_phase(lds, 1024, S, E); });
                RUN({ { DftOrder S{(const char*)(ws + OFF_DFTM), (const char*)(ws + OFF_FT), G, c}; EpiDft E{(bf16_t*)(ws + OFF_Y)}; gemm_phase(lds, 4096, S, E); }
                      if (l == 0) { DftCOrder S{(const char*)(ws + OFF_DFTMC), (const char*)(ws + OFF_FTC), G, c}; EpiDft E{(bf16_t*)(ws + OFF_Y)}; gemm_phase(lds, 256, S, E); }
                      __syncthreads();
                      dft_nyquist(P);
                      { unsigned* q = (unsigned*)(ws + OFF_BAR) + XCD_BAR_WORDS + 16 * (8 * l + (c & 7));
                        const int lg = lru_pass1(P, l, lds, q); gmlp_items(P, l, lg, q); } });
                RUN(lru_scan(P, l));
                RUN({ SplitOrder S{(const char*)(ws + OFF_Y), (const char*)(ws + OFF_WOUT + l * SZ_WOUT1), l == 1 ? 0 : 2, G, c, (size_t)256 * 1280 * 2, 20};
                      EpiRes E{P.out, Hc, MODl + 5 * 1024, (float*)(ws + OFF_PART), 1.0f, 0}; gemm_phase(lds, 1280, S, E); });
                RUN(phase_norm(P, l, 2, l == 0 ? 3 : 0));
            }
            RUN({ StaticOrder S{(const char*)(ws + OFF_XN), (const char*)(ws + OFF_WGU + (l * 2 + f) * SZ_WGU1), (l == 1 && f == 1) ? 128 : NPAN, 22, G, c, (size_t)256 * 1024 * 2, 16};
                  EpiGU E{(bf16_t*)(ws + OFF_ACT)}; gemm_phase(lds, 1024, S, E); });
            RUN({ SplitOrder S{(const char*)(ws + OFF_ACT), (const char*)(ws + OFF_WDN + (l * 2 + f) * SZ_WDN1), (l == 1 && f == 1) ? 0 : (l == 1 ? 2 : 1), G, c, (size_t)256 * DFF * 2, 44};
                  EpiRes E{P.out, Hc, MODl + (f == 0 ? 2 : 8) * 1024, (float*)(ws + OFF_PART), 0.5f, 0}; gemm_phase(lds, DFF, S, E);
                  if (l == 0 && c >= 64) { if (f == 0) { prep_dft(P, lds, c - 64, 192); prep_weights(P, lds, 0, c - 64, 192, 0x7f & ~(1 | 4)); } else prep_weights(P, lds, 1, c - 64, 192, 0x7f); } });
        }
        if (l == 0) RUN(phase_norm(P, 1, 0, 1)); else RUN(phase_final(P));
    }
#undef RUN
#ifdef PROBE
    xcd_barrier(bar);
#if PROBE == 1
    for (int i = 0; i < 40; ++i) xcd_barrier(bar);
#elif PROBE == 2
    for (int i = 0; i < 3; ++i) { gmlp_items(P, 1); lru_pass1(P, 1, lds); xcd_barrier(bar); lru_scan(P, 1); xcd_barrier(bar); }
#elif PROBE == 3
    for (int i = 0; i < 2; ++i) { phase_prep(P, lds); xcd_barrier(bar); }
#endif
#endif
}
constexpr int N_PHASES = 2 + 2 * 11;

extern "C" void kernel_launch(void* const* d_in, const int* in_sizes, int n_in, void* d_out, int out_size, void* d_ws, size_t ws_size, hipStream_t stream) {
    static int grid = 0;
    if (grid == 0) {
        if (n_in != 19 || out_size != TL * D || ws_size < WS_END) { fprintf(stderr, "kernel_launch: unexpected shapes (n_in %d out %d ws %zu need %zu)\n", n_in, out_size, ws_size, (size_t)WS_END); grid = -1; return; }
        int dev = 0, cus = 0, per_cu = 0;
        hipGetDevice(&dev); hipDeviceGetAttribute(&cus, hipDeviceAttributeMultiprocessorCount, dev);
        if (hipFuncSetAttribute((const void*)mega, hipFuncAttributeMaxDynamicSharedMemorySize, LDS_BYTES) != hipSuccess) { fprintf(stderr, "kernel_launch: hipFuncSetAttribute failed\n"); grid = -1; return; }
        hipOccupancyMaxActiveBlocksPerMultiprocessor(&per_cu, (const void*)mega, 512, LDS_BYTES);
        (void)hipGetLastError();
        if (per_cu < 1) per_cu = 1;
        grid = cus;
    }
    if (grid < 0) return;
    Params p{};
    p.x = (const float*)d_in[0]; p.c = (const float*)d_in[1]; p.ctx = (const float*)d_in[2]; p.c_ctx = (const float*)d_in[3]; p.w_mod = (const float*)d_in[4]; p.b_mod = (const float*)d_in[5];
    p.norm_g = (const float*)d_in[6]; p.w_gu = (const float*)d_in[7]; p.w_down = (const float*)d_in[8]; p.w_in = (const float*)d_in[9]; p.w_out = (const float*)d_in[10];
    p.conv_w = (const float*)d_in[11]; p.conv_b = (const float*)d_in[12]; p.lru_wg = (const float*)d_in[13]; p.lru_bg = (const float*)d_in[14]; p.lru_lam = (const float*)d_in[15];
    p.gmlp_ws = (const float*)d_in[16]; p.gmlp_bs = (const float*)d_in[17]; p.final_g = (const float*)d_in[18];
    p.out = (float*)d_out; p.ws = (unsigned char*)d_ws; p.ph_lo = 0; p.ph_hi = N_PHASES;
    if (hipMemsetAsync((char*)d_ws + OFF_BAR, 0, 16384, stream) != hipSuccess) { fprintf(stderr, "kernel_launch: hipMemsetAsync failed\n"); return; }
    void* args[] = {&p};
    hipError_t e = hipLaunchCooperativeKernel((const void*)mega, dim3(grid), dim3(512), args, LDS_BYTES, stream);
    if (e != hipSuccess) fprintf(stderr, "kernel_launch: cooperative launch failed: %s (grid %d)\n", hipGetErrorString(e), grid);
}
```

```cpp
#include <hip/hip_runtime.h>
#include <hip/hip_cooperative_groups.h>
#include <cstdio>
#include <cstdint>
namespace cg = cooperative_groups;

#define LAS __attribute__((address_space(3)))
#define GAS __attribute__((address_space(1)))
typedef unsigned short bf16_t;
typedef short bf16x8 __attribute__((ext_vector_type(8)));
typedef float f32x4 __attribute__((ext_vector_type(4)));
typedef float f32x2 __attribute__((ext_vector_type(2)));
typedef unsigned u32x4 __attribute__((ext_vector_type(4)));
typedef unsigned u32x2 __attribute__((ext_vector_type(2)));

constexpr int D = 1024, NB = 8, SEQ = 4096, CTXL = 256, TL = NB * SEQ, TC = NB * CTXL, T = TL + TC, NPAN = T / 256;
constexpr int DFF = 2816, ZW = 1280, YW = 1280, NMOD = 9;
constexpr int NQ = 68;

constexpr size_t SZ_WGU1 = (size_t)5632 * 1024 * 2, SZ_WDN1 = (size_t)1024 * 2816 * 2, SZ_WIN1 = (size_t)1792 * 1024 * 2, SZ_WOUT1 = (size_t)1024 * 1280 * 2;
constexpr size_t SZ_WGT1 = 131072 * 2, SZ_GWS1 = 65536 * 2;
constexpr size_t OFF_WGU = 0;
constexpr size_t OFF_WDN = OFF_WGU + 4 * SZ_WGU1;
constexpr size_t OFF_WIN = OFF_WDN + 4 * SZ_WDN1;
constexpr size_t OFF_WOUT = OFF_WIN + 2 * SZ_WIN1;
constexpr size_t OFF_WGT = OFF_WOUT + 2 * SZ_WOUT1;
constexpr size_t OFF_GWS = OFF_WGT + 2 * SZ_WGT1;
constexpr size_t OFF_MOD = OFF_GWS + 2 * SZ_GWS1;
constexpr size_t OFF_DFTM = OFF_MOD + (size_t)2 * 9 * 9216 * 4;
constexpr size_t OFF_DFTMC = OFF_DFTM + (size_t)8192 * 4096 * 2;
constexpr size_t OFF_HC = OFF_DFTMC + (size_t)512 * 256 * 2;
constexpr size_t OFF_XN = OFF_HC + (size_t)TC * 1024 * 4;
constexpr size_t OFF_AB = OFF_XN;
constexpr size_t OFF_AGG = OFF_AB + (size_t)T * 512 * 2 * 4;
constexpr size_t OFF_SP8 = OFF_AGG + (size_t)NB * NQ * 2 * 2 * 512 * 4;
constexpr size_t OFF_BAR = OFF_SP8 + 8192;
constexpr size_t OFF_PART = OFF_BAR + 16384;
constexpr size_t OFF_U = OFF_PART + (size_t)TC * 1024 * 4;
constexpr size_t OFF_ACT = OFF_U;
constexpr size_t OFF_Z = OFF_U;
constexpr size_t OFF_Y = OFF_Z + (size_t)T * ZW * 2;
constexpr size_t OFF_VT = OFF_Y + (size_t)T * YW * 2;
constexpr size_t OFF_VTC = OFF_VT + (size_t)NB * 256 * 4096 * 2;
constexpr size_t OFF_FT = OFF_VTC + (size_t)NB * 256 * 256 * 2;
constexpr size_t OFF_FTC = OFF_FT + (size_t)NB * 256 * 4096 * 2;
constexpr size_t U_END1 = OFF_FTC + (size_t)NB * 256 * 256 * 2;
constexpr size_t OFF_PART2 = OFF_FT;
constexpr size_t OFF_PART3 = OFF_FT + (size_t)TC * 1024 * 4;
static_assert(OFF_FT >= OFF_ACT + (size_t)T * DFF * 2 && OFF_PART3 + (size_t)TC * 1024 * 4 <= U_END1, "partial buffers must lie beyond ACT inside the FT region");
constexpr size_t U_END2 = OFF_ACT + (size_t)T * DFF * 2;
constexpr size_t WS_END = U_END1 > U_END2 ? U_END1 : U_END2;

constexpr int LDS_BYTES = 151552;

struct Params {
    const float *x, *c, *ctx, *c_ctx, *w_mod, *b_mod, *norm_g, *w_gu, *w_down, *w_in, *w_out, *conv_w, *conv_b, *lru_wg, *lru_bg, *lru_lam, *gmlp_ws, *gmlp_bs, *final_g;
    float* out; unsigned char* ws; int ph_lo, ph_hi;
};

__device__ __forceinline__ float bf2f(unsigned short b) { return __uint_as_float(((unsigned)b) << 16); }
__device__ __forceinline__ unsigned f2bf(float f) { unsigned u = __float_as_uint(f); return (u + 0x7fffu + ((u >> 16) & 1u)) >> 16; }
__device__ __forceinline__ unsigned cvt_pk_bf16(float lo, float hi) { unsigned r; asm volatile("v_cvt_pk_bf16_f32 %0, %1, %2" : "=v"(r) : "v"(lo), "v"(hi)); return r; }
__device__ __forceinline__ float wave_sum(float v) {
#pragma unroll
    for (int o = 1; o < 64; o <<= 1) v += __shfl_xor(v, o);
    return v;
}
__device__ __forceinline__ float silu_f(float g) { return g * __builtin_amdgcn_rcpf(1.0f + __expf(-g)); }
__device__ __forceinline__ float gelu_tanh_f(float x) { const float u = 1.5957691216f * (x + 0.044715f * x * x * x); return x * __builtin_amdgcn_rcpf(1.0f + __expf(-u)); }
__device__ __forceinline__ float sigmoid_fast(float x) { return __builtin_amdgcn_rcpf(1.0f + __expf(-x)); }

constexpr int BM = 256, BK = 64, HALF = 128, HTB = HALF * BK * 2, NXCD = 8, WGM = 8;
__device__ __forceinline__ int lds_byte(int r, int c) { const int st = (r >> 4) * 2 + (c >> 5), rr = r & 15, cc = c & 31, ob = rr * 64 + cc * 2; return st * 1024 + (ob ^ (((ob >> 9) & 1) << 5)); }
__device__ __forceinline__ void stage_rc(int b, int& R, int& C) { const int st = b / 1024, sb = b % 1024, swz = sb ^ (((sb >> 9) & 1) << 5); R = (st >> 1) * 16 + swz / 64; C = (st & 1) * 32 + (swz % 64) / 2; }
__device__ __forceinline__ int perm32(int rho) { const int n = rho >> 4, i = rho & 15; return 8 * (i >> 2) + 4 * n + (i & 3); }

struct Unit { const char* a; const char* b; int pm, pn, kind, pad; };

__device__ __forceinline__ bool tile_map(long L, int nM, int nN, int& pm, int& pn) {
    const int nwg = nM * nN; if (L >= nwg) return false;
    int wgid = (int)L; { const int q = nwg / NXCD, r = nwg % NXCD, xcd = wgid % NXCD, off = wgid / NXCD; wgid = (xcd < r ? xcd * (q + 1) : r * (q + 1) + (xcd - r) * q) + off; }
    const int nig = WGM * nN, gid = wgid / nig, fm = gid * WGM, gsz = (nM - fm) < WGM ? (nM - fm) : WGM;
    pm = fm + ((wgid % nig) % gsz); pn = (wgid % nig) / gsz; return true;
}
struct StaticOrder {
    const char* A; const char* Bt; int nM, nN, G, c; size_t tstep; int nt;
    __device__ __forceinline__ bool next(int i, Unit& u) const {
        int pm, pn; if (!tile_map((long)i * G + c, nM, nN, pm, pn)) return false;
        u.a = A + (size_t)pm * tstep; u.b = Bt + (size_t)pn * tstep; u.pm = pm; u.pn = pn; u.kind = 0; u.pad = nt; return true;
    }
};
struct SplitOrder {
    const char* A; const char* Bt; int ctx, G, c; size_t tstep; int nt;
    __device__ __forceinline__ bool next(int i, Unit& u) const {
        const int L = i * G + c;
        if (L < 512) { int pm, pn; tile_map(L, 128, 4, pm, pn); u.a = A + (size_t)pm * tstep; u.b = Bt + (size_t)pn * tstep; u.pm = pm; u.pn = pn; u.kind = 0; u.pad = nt; return true; }
        const int sidx = L - 512; if (sidx >= 64 * ctx) return false;
        int id, ks, t0, un;
        if (ctx == 1) { id = sidx >> 1; ks = sidx & 1; un = nt >> 1; t0 = ks * un; }
        else { id = sidx >> 2; ks = sidx & 3; const int qa = ((nt >> 2) + 1) & ~1, qb = (nt >> 1) - qa;
            t0 = ks == 0 ? 0 : ks == 1 ? qa : ks == 2 ? 2 * qa : 2 * qa + qb; un = ks < 2 ? qa : qb; }
        const int pm = 128 + (id >> 2), pn = id & 3; const size_t koff = (size_t)t0 * 128;
        u.a = A + (size_t)pm * tstep + koff; u.b = Bt + (size_t)pn * tstep + koff; u.pm = pm; u.pn = pn; u.kind = 1 + ks; u.pad = un; return true;
    }
};
struct InOrder {
    const char* XN; const char* W; int G, c;
    __device__ __forceinline__ bool next(int i, Unit& u) const {
        const size_t tstep = (size_t)256 * 1024 * 2; const long L = (long)i * G + c;
        if (L < NPAN * 5) { int pm, pn; tile_map(L, NPAN, 5, pm, pn); u.a = XN + (size_t)pm * tstep; u.b = W + (size_t)pn * tstep; u.pm = pm; u.pn = pn; u.kind = 0; u.pad = 16; return true; }
        const long L2 = L - NPAN * 5; if (L2 >= NPAN * 2) return false;
        const int which = (int)(L2 & 1), pnn = (int)(L2 >> 1);
        u.a = W + (size_t)(5 + which) * tstep; u.b = XN + (size_t)pnn * tstep; u.pm = which; u.pn = pnn; u.kind = 1; u.pad = 16; return true;
    }
};
struct DftOrder {
    const char* A; const char* FT; int G, c;
    __device__ __forceinline__ bool next(int i, Unit& u) const {
        if (i != 0 || c >= 128) return false;
        const int x = c & 7, qq = c >> 3, pi = 2 * x + (qq & 1), pm2 = pi < 8 ? pi : pi + 8, b = qq >> 1; const size_t tstep = (size_t)256 * 4096 * 2;
        u.a = A + (size_t)pm2 * tstep; u.b = FT + (size_t)b * tstep; u.pm = pm2; u.pn = b; u.kind = 0; u.pad = 64; return true;
    }
};
struct DftCOrder {
    const char* A; const char* FT; int G, c;
    __device__ __forceinline__ bool next(int i, Unit& u) const {
        const long L = (long)i * G + c; if (L >= 16) return false;
        const int pm2 = (int)(L & 1), b = (int)(L >> 1); const size_t tstep = (size_t)256 * 256 * 2;
        u.a = A + (size_t)pm2 * tstep; u.b = FT + (size_t)b * tstep; u.pm = pm2; u.pn = b; u.kind = 1; u.pad = 4; return true;
    }
};

__device__ __forceinline__ void store_bf16_tile(const f32x4 (&acc)[2][2][4][2], GAS bf16_t* p0, size_t ld, bool act, float scale) {
#pragma unroll
    for (int ai = 0; ai < 2; ++ai)
#pragma unroll
        for (int m = 0; m < 4; ++m) { GAS bf16_t* rowp = p0 + (size_t)(ai * HALF + m * 16) * ld;
#pragma unroll
            for (int bj = 0; bj < 2; ++bj) { f32x4 v0 = acc[ai][bj][m][0] * scale, v1 = acc[ai][bj][m][1] * scale;
                if (act) {
#pragma unroll
                    for (int j = 0; j < 4; ++j) { v0[j] = gelu_tanh_f(v0[j]); v1[j] = gelu_tanh_f(v1[j]); } }
                u32x4 w; w.x = cvt_pk_bf16(v0[0], v0[1]); w.y = cvt_pk_bf16(v0[2], v0[3]); w.z = cvt_pk_bf16(v1[0], v1[1]); w.w = cvt_pk_bf16(v1[2], v1[3]);
                *(GAS u32x4*)(rowp + bj * HALF) = w; } }
}
struct EpiGU {
    static constexpr bool PERM = true; bf16_t* ACT;
    __device__ __forceinline__ void operator()(const f32x4 (&acc)[2][2][4][2], const Unit& u, int wr, int wc, int fr, int fq) const {
        GAS bf16_t* p0 = (GAS bf16_t*)ACT + (size_t)(u.pm * BM + wr * 64 + fr) * DFF + u.pn * 128 + wc * 32 + 8 * fq;
#pragma unroll
        for (int ai = 0; ai < 2; ++ai)
#pragma unroll
            for (int m = 0; m < 4; ++m) { GAS bf16_t* rowp = p0 + (size_t)(ai * HALF + m * 16) * DFF;
                const f32x4 g0 = acc[ai][0][m][0], g1 = acc[ai][0][m][1], u0 = acc[ai][1][m][0], u1 = acc[ai][1][m][1]; f32x4 v0, v1;
#pragma unroll
                for (int hj = 0; hj < 2; ++hj) {
                    const f32x2 ga = (f32x2){g0[2 * hj], g0[2 * hj + 1]}, gb = (f32x2){g1[2 * hj], g1[2 * hj + 1]}, ua = (f32x2){u0[2 * hj], u0[2 * hj + 1]}, ub = (f32x2){u1[2 * hj], u1[2 * hj + 1]};
                    const f32x2 ta = ga * (-1.4426950408889634f), tb = gb * (-1.4426950408889634f);
                    const f32x2 da = (f32x2){__builtin_amdgcn_exp2f(ta.x), __builtin_amdgcn_exp2f(ta.y)} + 1.0f, db = (f32x2){__builtin_amdgcn_exp2f(tb.x), __builtin_amdgcn_exp2f(tb.y)} + 1.0f;
                    const f32x2 ra = (ga * ua) * (f32x2){__builtin_amdgcn_rcpf(da.x), __builtin_amdgcn_rcpf(da.y)}, rb = (gb * ub) * (f32x2){__builtin_amdgcn_rcpf(db.x), __builtin_amdgcn_rcpf(db.y)};
                    v0[2 * hj] = ra.x; v0[2 * hj + 1] = ra.y; v1[2 * hj] = rb.x; v1[2 * hj + 1] = rb.y; }
                u32x4 w; w.x = cvt_pk_bf16(v0[0], v0[1]); w.y = cvt_pk_bf16(v0[2], v0[3]); w.z = cvt_pk_bf16(v1[0], v1[1]); w.w = cvt_pk_bf16(v1[2], v1[3]);
                *(GAS u32x4*)rowp = w; }
    }
};
struct EpiRes {
    static constexpr bool PERM = false; float* Hl; float* Hc; const float* gate; float* PART; float mul; int padm;
    __device__ __forceinline__ void operator()(const f32x4 (&acc)[2][2][4][2], const Unit& u, int wr, int wc, int fr, int fq) const {
        const int vb = u.pm < 128 ? (u.pm >> 4) : 8;
        GAS float* base = (GAS float*)(u.pm < 128 ? Hl + (size_t)u.pm * 256 * 1024 : (u.kind >= 2 ? PART + (u.kind == 3 ? (size_t)((OFF_PART2 - OFF_PART) / 4) : u.kind == 4 ? (size_t)((OFF_PART3 - OFF_PART) / 4) : (size_t)0) : Hc) + (size_t)(u.pm - 128) * 256 * 1024);
        const int col0 = u.pn * BM + wc * 32 + 4 * fq; const GAS float* gp = (const GAS float*)gate + vb * 9216 + col0;
        GAS float* row0 = base + (size_t)(wr * 64 + fr) * 1024 + col0;
        if (u.kind >= 2) {
#pragma unroll
            for (int bj = 0; bj < 2; ++bj)
#pragma unroll
                for (int n = 0; n < 2; ++n) { const f32x4 gv = *(const GAS f32x4*)(gp + bj * HALF + n * 16) * mul;
#pragma unroll
                    for (int ai = 0; ai < 2; ++ai)
#pragma unroll
                        for (int m = 0; m < 4; ++m) *(GAS f32x4*)(row0 + (size_t)(ai * HALF + m * 16) * 1024 + bj * HALF + n * 16) = gv * acc[ai][bj][m][n]; }
            return; }
#pragma unroll
        for (int bj = 0; bj < 2; ++bj) {
            f32x4 hv[2][2][4];
#pragma unroll
            for (int n = 0; n < 2; ++n)
#pragma unroll
                for (int ai = 0; ai < 2; ++ai)
#pragma unroll
                    for (int m = 0; m < 4; ++m) hv[n][ai][m] = *(const GAS f32x4*)(row0 + (size_t)(ai * HALF + m * 16) * 1024 + bj * HALF + n * 16);
            asm volatile("" ::: "memory");
#pragma unroll
            for (int n = 0; n < 2; ++n) { const f32x4 gv = *(const GAS f32x4*)(gp + bj * HALF + n * 16) * mul;
#pragma unroll
                for (int ai = 0; ai < 2; ++ai)
#pragma unroll
                    for (int m = 0; m < 4; ++m) *(GAS f32x4*)(row0 + (size_t)(ai * HALF + m * 16) * 1024 + bj * HALF + n * 16) = hv[n][ai][m] + gv * acc[ai][bj][m][n]; }
            asm volatile("" ::: "memory"); }
    }
};
struct EpiIn {
    static constexpr bool PERM = true; bf16_t *Z, *VT, *VTC, *FT, *FTC;
    __device__ __forceinline__ void operator()(const f32x4 (&acc)[2][2][4][2], const Unit& u, int wr, int wc, int fr, int fq) const {
        GAS bf16_t* p0; size_t ld; bool act;
        if (u.kind == 0) { p0 = (GAS bf16_t*)Z + (size_t)(u.pm * BM + wr * 64 + fr) * ZW + u.pn * BM + wc * 32 + 8 * fq; ld = ZW; act = u.pn >= 2; }
        else { const int which = u.pm, pnn = u.pn; act = (which == 0);
            if (pnn < 128) { const int bb = pnn >> 4, n0 = (pnn & 15) * 256; ld = 4096; p0 = (GAS bf16_t*)(which ? FT : VT) + ((size_t)bb * 256 + wr * 64 + fr) * 4096 + n0 + wc * 32 + 8 * fq; }
            else { const int bb = pnn - 128; ld = 256; p0 = (GAS bf16_t*)(which ? FTC : VTC) + ((size_t)bb * 256 + wr * 64 + fr) * 256 + wc * 32 + 8 * fq; } }
        store_bf16_tile(acc, p0, ld, act, 1.0f);
    }
};
struct EpiDft {
    static constexpr bool PERM = true; bf16_t* Y;
    __device__ __forceinline__ void operator()(const f32x4 (&acc)[2][2][4][2], const Unit& u, int wr, int wc, int fr, int fq) const {
        if (u.kind == 0) {
            const int k0 = (u.pm & 15) * 256 + wr * 64 + fr, colbase = 768 + 256 * (u.pm >> 4); const unsigned flip = (u.pm >> 4) ? 0x80008000u : 0u; const float scale = 1.0f / 512.0f;
            GAS bf16_t* yb = (GAS bf16_t*)Y + (size_t)u.pn * 4096 * YW + colbase + wc * 32 + 8 * fq;
#pragma unroll
            for (int ai = 0; ai < 2; ++ai)
#pragma unroll
                for (int m = 0; m < 4; ++m) { const int k = k0 + ai * HALF + m * 16;
#pragma unroll
                    for (int bj = 0; bj < 2; ++bj) { const f32x4 v0 = acc[ai][bj][m][0] * scale, v1 = acc[ai][bj][m][1] * scale;
                        u32x4 w; w.x = cvt_pk_bf16(v0[0], v0[1]); w.y = cvt_pk_bf16(v0[2], v0[3]); w.z = cvt_pk_bf16(v1[0], v1[1]); w.w = cvt_pk_bf16(v1[2], v1[3]);
                        *(GAS u32x4*)(yb + (size_t)k * YW + bj * HALF) = w;
                        if (k != 0) { u32x4 wm; wm.x = w.x ^ flip; wm.y = w.y ^ flip; wm.z = w.z ^ flip; wm.w = w.w ^ flip; *(GAS u32x4*)(yb + (size_t)(4096 - k) * YW + bj * HALF) = wm; } } }
        } else {
            GAS bf16_t* p0 = (GAS bf16_t*)Y + (size_t)(TL + u.pn * 256 + wr * 64 + fr) * YW + 768 + 256 * u.pm + wc * 32 + 8 * fq;
            store_bf16_tile(acc, p0, YW, false, 1.0f / 128.0f);
        }
    }
};

template <class Epi, class Sched>
__device__ __forceinline__ void gemm_phase(LAS unsigned char* lds, const int K, const Sched& S, const Epi& E) {
    int tid = threadIdx.x; asm volatile("" : "+v"(tid));
    const int wid = __builtin_amdgcn_readfirstlane(tid >> 6), lane = tid & 63, wr = wid >> 2, wc = wid & 3, fr = lane & 15, fq = lane >> 4;
    unsigned voffA[2], voffB[2];
#pragma unroll
    for (int i = 0; i < 2; ++i) { int R, C; stage_rc(tid * 16 + i * 8192, R, C); const int Rb = Epi::PERM ? ((R & ~31) + perm32(R & 31)) : R;
        voffA[i] = (unsigned)(R * K + C) * 2u; voffB[i] = (unsigned)(Rb * K + C) * 2u; }
    const size_t kstep = (size_t)(BK * 2);
    const size_t hstep = (size_t)HALF * K * 2;
    const unsigned ldsw = (unsigned)wid * 1024u;
    const int aoff = lds_byte(wr * 64 + fr, fq * 8), boff = lds_byte(wc * 32 + fr, fq * 8);
#define PG8_SA(b, h) (((b) * 2 + (h)) * HTB)
#define PG8_SB(b, h) ((4 + (b) * 2 + (h)) * HTB)
#define PG8_STAGE(bufoff, gbase, voff) do { _Pragma("unroll") for (int _i = 0; _i < 2; ++_i) \
        __builtin_amdgcn_global_load_lds((const unsigned*)((const char*)(gbase) + (voff)[_i]), (LAS unsigned*)(lds + (bufoff) + ldsw + _i * 8192), 16, 0, 0); } while (0)
#define PG8_LDA(dst, b, h) do { _Pragma("unroll") for (int m = 0; m < 4; ++m) _Pragma("unroll") for (int k = 0; k < 2; ++k) dst[m][k] = *(const LAS bf16x8*)(lds + PG8_SA(b, h) + aoff + m * 2048 + k * 1024); } while (0)
#define PG8_LDB(dst, b, h) do { _Pragma("unroll") for (int n = 0; n < 2; ++n) _Pragma("unroll") for (int k = 0; k < 2; ++k) dst[n][k] = *(const LAS bf16x8*)(lds + PG8_SB(b, h) + boff + n * 2048 + k * 1024); } while (0)
#define PG8_MMA(ai, bj, At, Bt) do { __builtin_amdgcn_s_setprio(1); _Pragma("unroll") for (int m = 0; m < 4; ++m) _Pragma("unroll") for (int n = 0; n < 2; ++n) _Pragma("unroll") for (int k = 0; k < 2; ++k) \
        acc[ai][bj][m][n] = __builtin_amdgcn_mfma_f32_16x16x32_bf16(Bt[n][k], At[m][k], acc[ai][bj][m][n], 0, 0, 0); __builtin_amdgcn_s_setprio(0); } while (0)
#define PG8_WAIT_V(n) asm volatile("s_waitcnt vmcnt(" #n ")" ::: "memory")
#define PG8_WAIT_L(n) asm volatile("s_waitcnt lgkmcnt(" #n ")" ::: "memory")
#define PG8_BAR __builtin_amdgcn_s_barrier()
#define PG8_SCHED __builtin_amdgcn_sched_barrier(0)
    Unit cur, nxt; int ui = 0;
    if (!S.next(0, cur)) return;
    f32x4 acc[2][2][4][2];
#pragma unroll
    for (int a = 0; a < 2; ++a)
#pragma unroll
        for (int b = 0; b < 2; ++b)
#pragma unroll
            for (int m = 0; m < 4; ++m)
#pragma unroll
                for (int n = 0; n < 2; ++n) acc[a][b][m][n] = (f32x4){0.f, 0.f, 0.f, 0.f};
    bf16x8 At[4][2], B0[2][2], B1[2][2];
    const char* cA = cur.a; const char* cB = cur.b;
    PG8_STAGE(PG8_SB(0, 0), cB, voffB); PG8_STAGE(PG8_SB(0, 1), cB + hstep, voffB); PG8_STAGE(PG8_SA(0, 0), cA, voffA); PG8_STAGE(PG8_SA(0, 1), cA + hstep, voffA);
    if (wr == 1) PG8_BAR;
    PG8_WAIT_V(2); PG8_BAR;
    PG8_STAGE(PG8_SB(1, 0), cB + kstep, voffB); PG8_STAGE(PG8_SA(1, 0), cA + kstep, voffA); PG8_STAGE(PG8_SB(1, 1), cB + hstep + kstep, voffB);
    PG8_WAIT_V(6); PG8_BAR;
    for (;;) {
        const bool has_next = S.next(ui + 1, nxt);
        const char* nA = has_next ? nxt.a : cA; const char* nB = has_next ? nxt.b : cB;
        const int nt = cur.pad;
#pragma unroll 1
        for (int t = 0; t < nt; t += 2) {
            const bool last = (t == nt - 2);
            const char* a1 = cA + (size_t)(t + 1) * kstep;
            const char* a2 = last ? nA : cA + (size_t)(t + 2) * kstep; const char* b2 = last ? nB : cB + (size_t)(t + 2) * kstep;
            const char* a3 = a2 + kstep; const char* b3 = b2 + kstep;
            PG8_LDB(B0, 0, 0); PG8_LDB(B1, 0, 1); PG8_SCHED; PG8_LDA(At, 0, 0); PG8_STAGE(PG8_SA(1, 1), a1 + hstep, voffA);
            PG8_WAIT_V(8); PG8_WAIT_L(0); PG8_BAR; PG8_MMA(0, 0, At, B0); PG8_MMA(0, 1, At, B1); PG8_BAR; PG8_SCHED;
            PG8_LDA(At, 0, 1); PG8_STAGE(PG8_SB(0, 0), b2, voffB); PG8_STAGE(PG8_SB(0, 1), b2 + hstep, voffB); PG8_STAGE(PG8_SA(0, 0), a2, voffA);
            PG8_WAIT_V(8); PG8_WAIT_L(0); PG8_BAR; PG8_MMA(1, 0, At, B0); PG8_MMA(1, 1, At, B1); PG8_BAR; PG8_SCHED;
            PG8_LDB(B0, 1, 0); PG8_LDB(B1, 1, 1); PG8_SCHED; PG8_LDA(At, 1, 0); PG8_STAGE(PG8_SA(0, 1), a2 + hstep, voffA);
            PG8_WAIT_V(8); PG8_WAIT_L(0); PG8_BAR; PG8_MMA(0, 0, At, B0); PG8_MMA(0, 1, At, B1); PG8_BAR; PG8_SCHED;
            PG8_LDA(At, 1, 1); PG8_STAGE(PG8_SB(1, 0), b3, voffB); PG8_STAGE(PG8_SB(1, 1), b3 + hstep, voffB); PG8_STAGE(PG8_SA(1, 0), a3, voffA);
            PG8_WAIT_V(8); PG8_WAIT_L(0); PG8_BAR; PG8_MMA(1, 0, At, B0); PG8_MMA(1, 1, At, B1); PG8_BAR; PG8_SCHED;
        }
        if (wr == 0) PG8_BAR;
        E(acc, cur, wr, wc, fr, fq);
        if (!has_next) break;
#pragma unroll
        for (int a = 0; a < 2; ++a)
#pragma unroll
            for (int b = 0; b < 2; ++b)
#pragma unroll
                for (int m = 0; m < 4; ++m)
#pragma unroll
                    for (int n = 0; n < 2; ++n) acc[a][b][m][n] = (f32x4){0.f, 0.f, 0.f, 0.f};
        cur = nxt; cA = nA; cB = nB; ++ui;
        if (wr == 1) PG8_BAR;
    }
    PG8_WAIT_V(0);
    PG8_BAR;
#undef PG8_SA
#undef PG8_SB
#undef PG8_STAGE
#undef PG8_LDA
#undef PG8_LDB
#undef PG8_MMA
#undef PG8_WAIT_V
#undef PG8_WAIT_L
#undef PG8_BAR
#undef PG8_SCHED
}

__device__ __forceinline__ void transpose_item(const float* W, int ldw, int k0, int n0, bf16_t* WT, int ldt, int drow0, int dk0, LAS float* scr, int lane) {
    float tv[32];
#pragma unroll
    for (int i = 0; i < 32; ++i) { const int kk = 2 * i + (lane >> 5); tv[i] = W[(size_t)(k0 + kk) * ldw + n0 + (lane & 31)]; }
#pragma unroll
    for (int i = 0; i < 32; ++i) { const int kk = 2 * i + (lane >> 5); scr[kk * 33 + (lane & 31)] = tv[i]; }
    asm volatile("s_waitcnt lgkmcnt(0)" ::: "memory");
    const int c = lane & 7;
#pragma unroll
    for (int j = 0; j < 4; ++j) { const int n = (lane >> 3) + 8 * j; const LAS float* s = scr + (8 * c) * 33 + n;
        u32x4 o; o.x = cvt_pk_bf16(s[0 * 33], s[1 * 33]); o.y = cvt_pk_bf16(s[2 * 33], s[3 * 33]); o.z = cvt_pk_bf16(s[4 * 33], s[5 * 33]); o.w = cvt_pk_bf16(s[6 * 33], s[7 * 33]);
        *(GAS u32x4*)((GAS bf16_t*)WT + (size_t)(drow0 + n) * ldt + dk0 + 8 * c) = o; }
    asm volatile("s_waitcnt lgkmcnt(0)" ::: "memory");
}

__device__ __forceinline__ void prep_dft(const Params& P, LAS unsigned char* lds, int bid, int G) {
    int tid = threadIdx.x; asm volatile("" : "+v"(tid));
    unsigned char* ws = P.ws;
    LAS unsigned short* tabc = (LAS unsigned short*)(lds + 131072);
    LAS unsigned short* tabs = tabc + 4096;
    for (int i = tid; i < 4096; i += 512) { float s, c; sincospif((float)i * (1.0f / 2048.0f), &s, &c); tabc[i] = (unsigned short)f2bf(c); tabs[i] = (unsigned short)f2bf(s); }
    __syncthreads();
    { bf16_t* DFTM = (bf16_t*)(ws + OFF_DFTM);
      for (int rr = bid; rr < 4096; rr += G) { const int r = ((rr >> 11) << 12) + (rr & 2047); const int k = r & 4095;   const LAS unsigned short* tb = (r >> 12) ? tabs : tabc; const int n0 = tid * 8; unsigned e[8];
#pragma unroll
          for (int j = 0; j < 8; ++j) e[j] = tb[(k * (n0 + j)) & 4095];
          u32x4 o; o.x = e[0] | (e[1] << 16); o.y = e[2] | (e[3] << 16); o.z = e[4] | (e[5] << 16); o.w = e[6] | (e[7] << 16);
          *(GAS u32x4*)((GAS bf16_t*)DFTM + (size_t)r * 4096 + n0) = o; }
      bf16_t* DFTMC = (bf16_t*)(ws + OFF_DFTMC);
      for (int it = bid; it < 32; it += G) { const int r = it * 16 + (tid >> 5), n0 = (tid & 31) * 8, k = r & 255; const LAS unsigned short* tb = (r >> 8) ? tabs : tabc; unsigned e[8];
#pragma unroll
          for (int j = 0; j < 8; ++j) e[j] = tb[((k * (n0 + j)) & 255) << 4];
          u32x4 o; o.x = e[0] | (e[1] << 16); o.y = e[2] | (e[3] << 16); o.z = e[4] | (e[5] << 16); o.w = e[6] | (e[7] << 16);
          *(GAS u32x4*)((GAS bf16_t*)DFTMC + (size_t)r * 256 + n0) = o; } }
    __syncthreads();
}
__device__ __forceinline__ void prep_weights(const Params& P, LAS unsigned char* lds, int lay, int bid, int G, int sel) {
    int tid = threadIdx.x; asm volatile("" : "+v"(tid)); const int lane = tid & 63, wave = tid >> 6;
    unsigned char* ws = P.ws;
    LAS float* tab64 = (LAS float*)(lds + 131072 + 16384);
    if (tid < 64) tab64[tid] = cospif((float)tid * (1.0f / 32.0f));
    __syncthreads();
    { LAS float* scr = (LAS float*)(lds + wave * 16384);
      const int gw = bid * 8 + wave, NGW = G * 8;
      constexpr int I_GU = 16 * 176, I_DN = 44 * 32, I_IN = 16 * 56, I_OUT = 12 * 32;
      constexpr int NIT = 2 * I_GU + 2 * I_DN + I_IN + I_OUT;
      for (int it = gw; it < NIT; it += NGW) { int r = it;
          if (r < 2 * I_GU) { if (!((sel >> (r / I_GU)) & 1)) continue; const int mat = lay * 2 + r / I_GU, ii = r % I_GU, kb = ii / 176, nb = ii % 176, n0 = nb * 32;
              const int drow = n0 < DFF ? (n0 >> 7) * 256 + (n0 & 127) : ((n0 - DFF) >> 7) * 256 + 128 + ((n0 - DFF) & 127);
              transpose_item(P.w_gu + (size_t)mat * 1024 * 5632, 5632, kb * 64, n0, (bf16_t*)(ws + OFF_WGU + mat * SZ_WGU1), 1024, drow, kb * 64, scr, lane); continue; }
          r -= 2 * I_GU;
          if (r < 2 * I_DN) { if (!((sel >> (2 + r / I_DN)) & 1)) continue; const int mat = lay * 2 + r / I_DN, ii = r % I_DN, kb = ii / 32, nb = ii % 32;
              transpose_item(P.w_down + (size_t)mat * DFF * 1024, 1024, kb * 64, nb * 32, (bf16_t*)(ws + OFF_WDN + mat * SZ_WDN1), DFF, nb * 32, kb * 64, scr, lane); continue; }
          r -= 2 * I_DN;
          if (r < I_IN) { if (!(sel & 16)) continue; const int mat = lay, kb = r / 56, nb = r % 56;
              transpose_item(P.w_in + (size_t)mat * 1024 * 1792, 1792, kb * 64, nb * 32, (bf16_t*)(ws + OFF_WIN + mat * SZ_WIN1), 1024, nb * 32, kb * 64, scr, lane); continue; }
          r -= I_IN;
          if (sel & 32) { const int mat = lay, kb = r / 32, nb = r % 32;
              transpose_item(P.w_out + (size_t)mat * 1024 * 1024, 1024, kb * 64, nb * 32, (bf16_t*)(ws + OFF_WOUT + mat * SZ_WOUT1), 1280, nb * 32, kb * 64, scr, lane); } } }
    { const int gt = bid * 512 + tid, NGT = G * 512; const int l = lay;
      for (int idx = gt; idx < ((sel & 32) ? 256 * 1024 : 0); idx += NGT) { const int n = idx & 1023, gj = (idx >> 10) & 255, g = gj >> 6, j = gj & 63;
          const float* wp = P.w_out + (size_t)l * 1024 * 1024 + (size_t)(768 + g * 64) * 1024 + n; float cs = 0.f, sn = 0.f;
#pragma unroll 1
          for (int m0 = 0; m0 < 64; m0 += 32) { float wv[32];
#pragma unroll
              for (int m = 0; m < 32; ++m) wv[m] = wp[(size_t)(m0 + m) * 1024];
#pragma unroll
              for (int m = 0; m < 32; ++m) { const int t = ((m0 + m) * j) & 63; cs += tab64[t] * wv[m]; sn += tab64[(t + 48) & 63] * wv[m]; } }
          bf16_t* o = (bf16_t*)(ws + OFF_WOUT + l * SZ_WOUT1) + (size_t)n * 1280; o[768 + gj] = (bf16_t)f2bf(cs); o[1024 + gj] = (bf16_t)f2bf(-sn); }
      for (int i0 = gt; i0 < ((sel & 64) ? 131072 : 0); i0 += NGT) { const int idx = l * 131072 + i0; const int i = idx & 63, j = (idx >> 6) & 63, hi = idx >> 12;
          ((bf16_t*)(ws + OFF_WGT))[idx] = (bf16_t)f2bf(P.lru_wg[(size_t)hi * 4096 + i * 64 + j]); }
      for (int i0 = gt; i0 < ((sel & 64) ? 65536 : 0); i0 += NGT) { const int idx = l * 65536 + i0; ((bf16_t*)(ws + OFF_GWS))[idx] = (bf16_t)f2bf(P.gmlp_ws[idx]); } }
    __syncthreads();
}
__device__ __forceinline__ void phase_prep(const Params& P, LAS unsigned char* lds) {
    int tid = threadIdx.x; asm volatile("" : "+v"(tid)); const int lane = tid & 63, wave = tid >> 6, G = gridDim.x, bid = blockIdx.x;
    unsigned char* ws = P.ws;
    prep_weights(P, lds, 0, bid, G, 1 | 4);
    { const int gt = bid * 512 + tid, NGT = G * 512;
      for (int idx = gt; idx < 2048; idx += NGT) ((float*)(ws + OFF_SP8))[idx] = 8.0f * log1pf(expf(-P.lru_lam[idx])); }
    __syncthreads();
    { LAS float* sc = (LAS float*)lds;
      LAS float* red = (LAS float*)(lds + 36864);
      for (int i = tid; i < 9 * 1024; i += 512) { const int v = i >> 10, k = i & 1023; const float cv = v < 8 ? P.c[v * 1024 + k] : P.c_ctx[k]; sc[i] = cv / (1.0f + expf(-cv)); }
      __syncthreads();
      float* MOD = (float*)(ws + OFF_MOD);
      for (int it = bid; it < 288; it += G) { const int l = it / 144, col0 = (it % 144) * 64, kc = tid >> 4, cq = tid & 15;
          f32x4 a[9];
#pragma unroll
          for (int v = 0; v < 9; ++v) a[v] = (f32x4){0.f, 0.f, 0.f, 0.f};
          const float* wp = P.w_mod + (size_t)l * 1024 * 9216 + (size_t)(kc * 32) * 9216 + col0 + 4 * cq;
#pragma unroll 1
          for (int k0 = 0; k0 < 32; k0 += 16) { f32x4 wv[16];
#pragma unroll
              for (int k = 0; k < 16; ++k) wv[k] = *(const f32x4*)(wp + (size_t)(k0 + k) * 9216);
#pragma unroll
              for (int k = 0; k < 16; ++k) {
#pragma unroll
                  for (int v = 0; v < 9; ++v) a[v] += wv[k] * sc[v * 1024 + kc * 32 + k0 + k]; } }
#pragma unroll
          for (int v = 0; v < 9; ++v) *(LAS f32x4*)(red + (kc * 9 + v) * 64 + 4 * cq) = a[v];
          __syncthreads();
          for (int o = tid; o < 9 * 64; o += 512) { const int v = o >> 6, cc = o & 63; float s = P.b_mod[l * 9216 + col0 + cc];
#pragma unroll
              for (int q = 0; q < 32; ++q) s += red[(q * 9 + v) * 64 + cc];
              MOD[(size_t)(l * 9 + v) * 9216 + col0 + cc] = s; }
          __syncthreads(); } }
}

__device__ __forceinline__ void norm_store(const f32x4 (&v)[4], const float* modv, int shift_k, int scale_k, const float* g, bf16_t* xnrow, int lane) {
    float ss = 0.f;
#pragma unroll
    for (int j = 0; j < 4; ++j) ss += (v[j].x * v[j].x + v[j].y * v[j].y) + (v[j].z * v[j].z + v[j].w * v[j].w);
    const float rstd = 1.0f / sqrtf(wave_sum(ss) * (1.0f / 1024.0f) + 1e-6f);
#pragma unroll
    for (int j = 0; j < 4; ++j) { const int c0 = 4 * lane + 256 * j;
        const f32x4 gg = *(const f32x4*)(g + c0), sc = *(const f32x4*)(modv + scale_k * 1024 + c0), sh = *(const f32x4*)(modv + shift_k * 1024 + c0);
        const f32x4 y = v[j] * rstd * gg * (sc + 1.0f) + sh;
        u32x2 w; w.x = cvt_pk_bf16(y.x, y.y); w.y = cvt_pk_bf16(y.z, y.w); *(GAS u32x2*)((GAS bf16_t*)xnrow + c0) = w; }
}
__device__ __forceinline__ void phase_init(const Params& P) {
    int tid = threadIdx.x; asm volatile("" : "+v"(tid)); const int lane = tid & 63, wave = tid >> 6, gw = blockIdx.x * 8 + wave, NGW = gridDim.x * 8;
    float* Hc = (float*)(P.ws + OFF_HC); bf16_t* XN = (bf16_t*)(P.ws + OFF_XN); const float* MOD = (const float*)(P.ws + OFF_MOD);
    float fr4[4];
#pragma unroll
    for (int e = 0; e < 4; ++e) fr4[e] = 1.0f / powf(10000.0f, (float)(4 * lane + e) * (1.0f / 256.0f));
    const int sA = gw & 4095, sB = (gw + NGW) & 4095; f32x4 posA[4], posB[4];
#pragma unroll
    for (int e = 0; e < 4; ++e) { float s1, c1, s2, c2;
        sincosf((float)(sA >> 6) * fr4[e], &s1, &c1); sincosf((float)(sA & 63) * fr4[e], &s2, &c2); posA[0][e] = s1; posA[1][e] = c1; posA[2][e] = s2; posA[3][e] = c2;
        sincosf((float)(sB >> 6) * fr4[e], &s1, &c1); sincosf((float)(sB & 63) * fr4[e], &s2, &c2); posB[0][e] = s1; posB[1][e] = c1; posB[2][e] = s2; posB[3][e] = c2; }
#define IN_LOAD(R, V, SC, SH) do { const int _r = (R); const float* _xr = _r < TL ? P.x + (size_t)_r * 1024 : P.ctx + (size_t)(_r - TL) * 1024; const float* _mv = MOD + (size_t)(_r < TL ? (_r >> 12) : 8) * 9216; \
        _Pragma("unroll") for (int j = 0; j < 4; ++j) { const int c0 = 4 * lane + 256 * j; V[j] = *(const f32x4*)(_xr + c0); SC[j] = *(const f32x4*)(_mv + 1024 + c0); SH[j] = *(const f32x4*)(_mv + c0); } } while (0)
    f32x4 gg[4], v[4], sc[4], sh[4];
#pragma unroll
    for (int j = 0; j < 4; ++j) gg[j] = *(const f32x4*)(P.norm_g + 4 * lane + 256 * j);
    if (gw < T) IN_LOAD(gw, v, sc, sh);
    for (int r = gw; r < T; r += NGW) { const int rn = r + NGW; f32x4 vn[4], scn[4], shn[4];
        if (rn < T) IN_LOAD(rn, vn, scn, shn);
        __builtin_amdgcn_sched_barrier(0);
        float* hr;
        if (r < TL) { const int s = r & 4095;
            if (s == sA) {
#pragma unroll
                for (int j = 0; j < 4; ++j) v[j] += posA[j];
            } else if (s == sB) {
#pragma unroll
                for (int j = 0; j < 4; ++j) v[j] += posB[j];
            } else { const float rr = (float)(s >> 6), cc = (float)(s & 63);
#pragma unroll
                for (int e = 0; e < 4; ++e) { float s1, c1, s2, c2; sincosf(rr * fr4[e], &s1, &c1); sincosf(cc * fr4[e], &s2, &c2); v[0][e] += s1; v[1][e] += c1; v[2][e] += s2; v[3][e] += c2; }
            }
            hr = P.out + (size_t)r * 1024; }
        else hr = Hc + (size_t)(r - TL) * 1024;
        float ss = 0.f;
#pragma unroll
        for (int j = 0; j < 4; ++j) { *(f32x4*)(hr + 4 * lane + 256 * j) = v[j]; ss += (v[j].x * v[j].x + v[j].y * v[j].y) + (v[j].z * v[j].z + v[j].w * v[j].w); }
        const float rstd = 1.0f / sqrtf(wave_sum(ss) * (1.0f / 1024.0f) + 1e-6f);
#pragma unroll
        for (int j = 0; j < 4; ++j) { const f32x4 y = v[j] * rstd * gg[j] * (sc[j] + 1.0f) + sh[j];
            u32x2 w; w.x = cvt_pk_bf16(y.x, y.y); w.y = cvt_pk_bf16(y.z, y.w); *(GAS u32x2*)((GAS bf16_t*)XN + (size_t)r * 1024 + 4 * lane + 256 * j) = w; }
        if (rn < T) {
#pragma unroll
            for (int j = 0; j < 4; ++j) { v[j] = vn[j]; sc[j] = scn[j]; sh[j] = shn[j]; } }
    }
#undef IN_LOAD
}
#define NR_LOAD(R, V, SC, SH) do { const int _r = (R); const float* _hr = _r < TL ? P.out + (size_t)_r * 1024 : Hc + (size_t)(_r - TL) * 1024; const float* _mv = MOD + (size_t)(_r < TL ? (_r >> 12) : 8) * 9216; \
        _Pragma("unroll") for (int j = 0; j < 4; ++j) { const int c0 = 4 * lane + 256 * j; V[j] = *(const f32x4*)(_hr + c0); SC[j] = *(const f32x4*)(_mv + (3 * sub + 1) * 1024 + c0); SH[j] = *(const f32x4*)(_mv + (3 * sub) * 1024 + c0); } \
        if (addpart && _r >= TL) { const size_t _o = (size_t)(_r - TL) * 1024; const float* _pr = (const float*)(P.ws + OFF_PART) + _o; _Pragma("unroll") for (int j = 0; j < 4; ++j) V[j] += *(const f32x4*)(_pr + 4 * lane + 256 * j); \
            if (addpart > 1) { const float* _p2 = (const float*)(P.ws + OFF_PART2) + _o; const float* _p3 = (const float*)(P.ws + OFF_PART3) + _o; _Pragma("unroll") for (int j = 0; j < 4; ++j) V[j] += *(const f32x4*)(_p2 + 4 * lane + 256 * j) + *(const f32x4*)(_p3 + 4 * lane + 256 * j); } } } while (0)
__device__ __forceinline__ void phase_norm(const Params& P, int l, int sub, int addpart) {
    int tid = threadIdx.x; asm volatile("" : "+v"(tid)); const int lane = tid & 63, wave = tid >> 6; const int rbeg = blockIdx.x * 8 + wave, rstride = gridDim.x * 8, rend = T;
    const float* Hc = (const float*)(P.ws + OFF_HC); bf16_t* XN = (bf16_t*)(P.ws + OFF_XN); const float* MOD = (const float*)(P.ws + OFF_MOD) + (size_t)l * 9 * 9216;
    const float* g = P.norm_g + (l * 3 + sub) * 1024; f32x4 gg[4];
#pragma unroll
    for (int j = 0; j < 4; ++j) gg[j] = *(const f32x4*)(g + 4 * lane + 256 * j);
    f32x4 v[4], sc[4], sh[4];
    if (rbeg < rend) NR_LOAD(rbeg, v, sc, sh);
    for (int r = rbeg; r < rend; r += rstride) { const int rn = r + rstride; f32x4 vn[4], scn[4], shn[4];
        if (rn < rend) NR_LOAD(rn, vn, scn, shn);
        __builtin_amdgcn_sched_barrier(0);
        if (addpart && r >= TL) { float* hw = (float*)(P.ws + OFF_HC) + (size_t)(r - TL) * 1024;
#pragma unroll
            for (int j = 0; j < 4; ++j) *(f32x4*)(hw + 4 * lane + 256 * j) = v[j]; }
        float ss = 0.f;
#pragma unroll
        for (int j = 0; j < 4; ++j) ss += (v[j].x * v[j].x + v[j].y * v[j].y) + (v[j].z * v[j].z + v[j].w * v[j].w);
        const float rstd = 1.0f / sqrtf(wave_sum(ss) * (1.0f / 1024.0f) + 1e-6f);
#pragma unroll
        for (int j = 0; j < 4; ++j) { const f32x4 y = v[j] * rstd * gg[j] * (sc[j] + 1.0f) + sh[j];
            u32x2 w; w.x = cvt_pk_bf16(y.x, y.y); w.y = cvt_pk_bf16(y.z, y.w); *(GAS u32x2*)((GAS bf16_t*)XN + (size_t)r * 1024 + 4 * lane + 256 * j) = w; }
        if (rn < rend) {
#pragma unroll
            for (int j = 0; j < 4; ++j) { v[j] = vn[j]; sc[j] = scn[j]; sh[j] = shn[j]; } }
    }
}
#undef NR_LOAD
__device__ __forceinline__ void phase_final(const Params& P) {
    int tid = threadIdx.x; asm volatile("" : "+v"(tid)); const int lane = tid & 63, wave = tid >> 6, gw = blockIdx.x * 8 + wave, NGW = gridDim.x * 8;
    f32x4 gg[4], v[4];
#pragma unroll
    for (int j = 0; j < 4; ++j) gg[j] = *(const f32x4*)(P.final_g + 4 * lane + 256 * j);
    if (gw < TL) {
#pragma unroll
        for (int j = 0; j < 4; ++j) v[j] = *(const f32x4*)(P.out + (size_t)gw * 1024 + 4 * lane + 256 * j); }
    for (int r = gw; r < TL; r += NGW) { float* hr = P.out + (size_t)r * 1024; const int rn = r + NGW; f32x4 vn[4];
        if (rn < TL) {
#pragma unroll
            for (int j = 0; j < 4; ++j) vn[j] = *(const f32x4*)(P.out + (size_t)rn * 1024 + 4 * lane + 256 * j); }
        __builtin_amdgcn_sched_barrier(0);
        float ss = 0.f;
#pragma unroll
        for (int j = 0; j < 4; ++j) ss += (v[j].x * v[j].x + v[j].y * v[j].y) + (v[j].z * v[j].z + v[j].w * v[j].w);
        const float rstd = 1.0f / sqrtf(wave_sum(ss) * (1.0f / 1024.0f) + 1e-6f);
#pragma unroll
        for (int j = 0; j < 4; ++j) *(f32x4*)(hr + 4 * lane + 256 * j) = v[j] * rstd * gg[j];
        if (rn < TL) {
#pragma unroll
            for (int j = 0; j < 4; ++j) v[j] = vn[j]; } }
}

__device__ __forceinline__ int queue_pull(unsigned* q, int lane) { unsigned nx = 0; if (lane == 0) nx = __hip_atomic_fetch_add(q, 1u, __ATOMIC_RELAXED, __HIP_MEMORY_SCOPE_AGENT); return 256 + (int)__builtin_amdgcn_readfirstlane(nx); }
__device__ __forceinline__ void gmlp_items(const Params& P, int l, int local, unsigned* q) {
    int tid = threadIdx.x; asm volatile("" : "+v"(tid)); const int lane = tid & 63, wslot = tid >> 6, fr = lane & 15, fq = lane >> 4;
    const GAS bf16_t* GWS = (const GAS bf16_t*)(P.ws + OFF_GWS + l * SZ_GWS1); const GAS bf16_t* Z = (const GAS bf16_t*)(P.ws + OFF_Z); GAS bf16_t* Y = (GAS bf16_t*)(P.ws + OFF_Y);
    const int xq = blockIdx.x & 7;
    for (; local < 680; local = queue_pull(q, lane)) { const int it = xq * 136 + (local - 544); const int ch = it >> 2, g = it & 3; const GAS bf16_t* VTb; int ldv;
        if (ch < 256) { const int b = ch >> 5, n0 = (ch & 31) * 128; VTb = (const GAS bf16_t*)(P.ws + OFF_VT) + ((size_t)b * 256 + g * 64) * 4096 + n0; ldv = 4096; }
        else { const int cc = ch - 256, b = cc >> 1, n0 = (cc & 1) * 128; VTb = (const GAS bf16_t*)(P.ws + OFF_VTC) + ((size_t)b * 256 + g * 64) * 256 + n0; ldv = 256; }
        bf16x8 Afv[4][4];
#pragma unroll
        for (int kk = 0; kk < 4; ++kk)
#pragma unroll
            for (int mt = 0; mt < 4; ++mt) Afv[kk][mt] = *(const GAS bf16x8*)(VTb + (size_t)(mt * 16 + fr) * ldv + kk * 32 + 8 * fq);
#pragma unroll 1
        for (int half = 0; half < 2; ++half) {
            bf16x8 Bfv[4][4]; u32x2 uua[4][4]; float bsv[4];
#pragma unroll
            for (int q = 0; q < 4; ++q) { const int p = 16 * (4 * half + q) + fr; const size_t row = (size_t)ch * 128 + p; bsv[q] = P.gmlp_bs[(l * 4 + g) * 128 + p];
#pragma unroll
                for (int kk = 0; kk < 4; ++kk) Bfv[q][kk] = *(const GAS bf16x8*)(GWS + ((size_t)(g * 128 + p)) * 128 + kk * 32 + 8 * fq);
#pragma unroll
                for (int mt = 0; mt < 4; ++mt) uua[q][mt] = *(const GAS u32x2*)(Z + row * ZW + 1024 + g * 64 + mt * 16 + 4 * fq); }
            __builtin_amdgcn_sched_barrier(0);
#pragma unroll
            for (int q = 0; q < 4; ++q) { const int p = 16 * (4 * half + q) + fr; const size_t row = (size_t)ch * 128 + p;
                f32x4 acc[4];
#pragma unroll
                for (int mt = 0; mt < 4; ++mt) acc[mt] = (f32x4){0.f, 0.f, 0.f, 0.f};
#pragma unroll
                for (int kk = 0; kk < 4; ++kk)
#pragma unroll
                    for (int mt = 0; mt < 4; ++mt) acc[mt] = __builtin_amdgcn_mfma_f32_16x16x32_bf16(Afv[kk][mt], Bfv[q][kk], acc[mt], 0, 0, 0);
#pragma unroll
                for (int mt = 0; mt < 4; ++mt) { const int d0 = mt * 16 + 4 * fq; const u32x2 uu = uua[q][mt];
                    const float u0 = __uint_as_float(uu.x << 16), u1 = __uint_as_float(uu.x & 0xffff0000u), u2 = __uint_as_float(uu.y << 16), u3 = __uint_as_float(uu.y & 0xffff0000u);
                    u32x2 o; o.x = cvt_pk_bf16(u0 * (acc[mt][0] + bsv[q]), u1 * (acc[mt][1] + bsv[q])); o.y = cvt_pk_bf16(u2 * (acc[mt][2] + bsv[q]), u3 * (acc[mt][3] + bsv[q]));
                    *(GAS u32x2*)(Y + row * YW + 512 + g * 64 + d0) = o; } }
        }
    }
}

__device__ __forceinline__ void dft_nyquist(const Params& P) {
    int tid = threadIdx.x; asm volatile("" : "+v"(tid)); const int lane = tid & 63;
    const GAS bf16_t* FT = (const GAS bf16_t*)(P.ws + OFF_FT); GAS bf16_t* Y = (GAS bf16_t*)(P.ws + OFF_Y);
    for (int wi = blockIdx.x * 8 + (tid >> 6); wi < NB * 256; wi += gridDim.x * 8) { const int b = wi >> 8, ch = wi & 255; const GAS bf16_t* fp = FT + ((size_t)b * 256 + ch) * 4096; float a = 0.f;
        u32x4 qv[8];
#pragma unroll
        for (int j = 0; j < 8; ++j) qv[j] = *(const GAS u32x4*)(fp + (size_t)(j * 64 + lane) * 8);
        __builtin_amdgcn_sched_barrier(0);
#pragma unroll
        for (int j = 0; j < 8; ++j) {
#pragma unroll
            for (int e = 0; e < 4; ++e) a += __uint_as_float(qv[j][e] << 16) - __uint_as_float(qv[j][e] & 0xffff0000u); }
        a = wave_sum(a);
        if (lane == 0) { GAS bf16_t* yr = Y + (size_t)(b * 4096 + 2048) * YW; yr[768 + ch] = (bf16_t)f2bf(a * (1.0f / 512.0f)); yr[1024 + ch] = (bf16_t)0; } }
}

__device__ __forceinline__ int lru_pass1(const Params& P, int l, LAS unsigned char* lds, unsigned* qw) {
    int tid = threadIdx.x; asm volatile("" : "+v"(tid)); const int lane = tid & 63, fr = lane & 15, fq = lane >> 4;
    const GAS bf16_t* Z = (const GAS bf16_t*)(P.ws + OFF_Z);
    const GAS bf16_t* WGT = (const GAS bf16_t*)(P.ws + OFF_WGT + l * SZ_WGT1); GAS float* AGG = (GAS float*)(P.ws + OFF_AGG); GAS unsigned* AB = (GAS unsigned*)(P.ws + OFF_AB);
    LAS unsigned short* xcS = (LAS unsigned short*)(lds + (tid >> 6) * 9216);
    LAS unsigned short* xaS = (LAS unsigned short*)(lds + 8 * 9216 + (tid >> 6) * 8704);
    const GAS float* SP8 = (const GAS float*)(P.ws + OFF_SP8);
    const int wslot = tid >> 6;
    const int xq = blockIdx.x & 7, jq = blockIdx.x >> 3;
    int local = jq >= 16 ? (jq - 16) * 8 + wslot : 128 + jq * 8 + wslot;
    for (;;) {
        if (local >= 544) break;
        const int wi = xq * 544 + local;
        const int it = wi >> 3, h = wi & 7;
        int b, j, q, Ls, r0seq;
        if (it < 512) { b = it >> 6; j = it & 63; q = 4 + j; Ls = 4096; r0seq = b * 4096; } else { const int t2 = it - 512; b = t2 >> 2; j = t2 & 3; q = j; Ls = 256; r0seq = TL + b * 256; }
        const int n0 = j * 64, r0 = r0seq + n0;
        {
            u32x4 tq[9];
#pragma unroll
            for (int jq = 0; jq < 9; ++jq) { const int qi = lane + 64 * jq, row = min(qi >> 3, 66), ch8 = qi & 7; const int n = n0 - 2 + row, nn = min(max(n, 0), Ls - 1);
                tq[jq] = *(const GAS u32x4*)(Z + (size_t)(r0seq + nn) * ZW + h * 64 + ch8 * 8); }
            __builtin_amdgcn_sched_barrier(0);
#pragma unroll
            for (int jq = 0; jq < 9; ++jq) { const int qi = lane + 64 * jq, row = qi >> 3, ch8 = qi & 7; if (row < 67) *(LAS u32x4*)(xaS + row * 64 + ch8 * 8) = tq[jq]; }
            asm volatile("s_waitcnt lgkmcnt(0)" ::: "memory");
            const int c = h * 64 + lane; const float* cw = P.conv_w + l * 4 * 512 + c; const float w0 = cw[0], w1 = cw[512], w2 = cw[1024], w3 = cw[1536], cb = P.conv_b[l * 512 + c];
            float xv[67];
#pragma unroll
            for (int i = 0; i < 67; ++i) { const int n = n0 - 2 + i; xv[i] = bf2f(xaS[i * 64 + lane]) * ((n >= 0 && n < Ls) ? 1.0f : 0.0f); }
#pragma unroll
            for (int p = 0; p < 64; ++p) { const float xc = cb + w0 * xv[p] + w1 * xv[p + 1] + w2 * xv[p + 2] + w3 * xv[p + 3]; xcS[p * 72 + lane] = (unsigned short)f2bf(xc); }
        }
        asm volatile("s_waitcnt lgkmcnt(0)" ::: "memory");
        bf16x8 Af[4][2];
#pragma unroll
        for (int mt = 0; mt < 4; ++mt)
#pragma unroll
            for (int kk = 0; kk < 2; ++kk) { const int row = 16 * (fr >> 2) + 4 * mt + (fr & 3); Af[mt][kk] = *(const LAS bf16x8*)(xcS + row * 72 + kk * 32 + 8 * fq); }
#pragma unroll 1
        for (int jt = 0; jt < 4; ++jt) { const int cl = 16 * jt + fr, c = h * 64 + cl;
            f32x4 acc[4][4];
#pragma unroll
            for (int mt = 0; mt < 4; ++mt)
#pragma unroll
                for (int dt = 0; dt < 4; ++dt) acc[mt][dt] = (f32x4){0.f, 0.f, 0.f, 0.f};
            bf16x8 Bfr[4][2];
#pragma unroll
            for (int dt = 0; dt < 4; ++dt)
#pragma unroll
                for (int kk = 0; kk < 2; ++kk) Bfr[dt][kk] = *(const GAS bf16x8*)(WGT + ((size_t)((dt * 8 + h) * 64 + cl)) * 64 + kk * 32 + 8 * fq);
            __builtin_amdgcn_sched_barrier(0);
#pragma unroll
            for (int dt = 0; dt < 4; ++dt)
#pragma unroll
                for (int kk = 0; kk < 2; ++kk) {
#pragma unroll
                    for (int mt = 0; mt < 4; ++mt) acc[mt][dt] = __builtin_amdgcn_mfma_f32_16x16x32_bf16(Af[mt][kk], Bfr[dt][kk], acc[mt][dt], 0, 0, 0); }
            u32x2 abw[16];
#pragma unroll
            for (int d = 0; d < 2; ++d) {
                const float bgr = P.lru_bg[((l * 2 + d) * 2 + 0) * 512 + c], bgi = P.lru_bg[((l * 2 + d) * 2 + 1) * 512 + c];
                const float sp8 = SP8[(l * 2 + d) * 512 + c];
#pragma unroll
                for (int mt = 0; mt < 4; ++mt)
#pragma unroll
                    for (int ip = 0; ip < 2; ++ip) { const int p = 16 * fq + 4 * mt + 2 * ip;
                        const f32x2 xcv = (f32x2){bf2f(xcS[p * 72 + cl]), bf2f(xcS[(p + 1) * 72 + cl])};
                        const f32x2 tr = ((f32x2){acc[mt][2 * d][2 * ip], acc[mt][2 * d][2 * ip + 1]} + bgr) * (-1.4426950408889634f);
                        const f32x2 ti = ((f32x2){acc[mt][2 * d + 1][2 * ip], acc[mt][2 * d + 1][2 * ip + 1]} + bgi) * (-1.4426950408889634f);
                        const f32x2 dr = (f32x2){__builtin_amdgcn_exp2f(tr.x), __builtin_amdgcn_exp2f(tr.y)} + 1.0f, di = (f32x2){__builtin_amdgcn_exp2f(ti.x), __builtin_amdgcn_exp2f(ti.y)} + 1.0f;
                        const f32x2 r = (f32x2){__builtin_amdgcn_rcpf(dr.x), __builtin_amdgcn_rcpf(dr.y)}, ig = (f32x2){__builtin_amdgcn_rcpf(di.x), __builtin_amdgcn_rcpf(di.y)};
                        const f32x2 la = r * (-sp8), x2 = la + la;
                        f32x2 q5 = x2 * 0.0083333333f + 0.041666668f; q5 = q5 * x2 + 0.16666667f; q5 = q5 * x2 + 0.5f; q5 = q5 * x2 + 1.0f; f32x2 em = -(x2 * q5);
                        if (__builtin_expect(__any((x2.x < -0.25f) || (x2.y < -0.25f)), 0)) {
                            if (x2.x < -0.25f) em.x = 1.0f - __expf(x2.x);
                            if (x2.y < -0.25f) em.y = 1.0f - __expf(x2.y); }
                        const f32x2 tl = la * 1.4426950408889634f; const f32x2 om = 1.0f - (f32x2){__builtin_amdgcn_exp2f(tl.x), __builtin_amdgcn_exp2f(tl.y)};
                        const f32x2 bvv = (f32x2){__builtin_amdgcn_sqrtf(em.x), __builtin_amdgcn_sqrtf(em.y)} * ig * xcv;
                        const unsigned wq0 = cvt_pk_bf16(om.x, bvv.x), wq1 = cvt_pk_bf16(om.y, bvv.y);
                        acc[mt][2 * d][2 * ip] = 1.0f - __uint_as_float(wq0 << 16); acc[mt][2 * d + 1][2 * ip] = __uint_as_float(wq0 & 0xffff0000u);
                        acc[mt][2 * d][2 * ip + 1] = 1.0f - __uint_as_float(wq1 << 16); acc[mt][2 * d + 1][2 * ip + 1] = __uint_as_float(wq1 & 0xffff0000u);
                        abw[mt * 4 + 2 * ip][d] = wq0; abw[mt * 4 + 2 * ip + 1][d] = wq1; }
                float Ar = 1.f, Br = 0.f;
#pragma unroll
                for (int s = 0; s < 16; ++s) { const int idx = d == 0 ? s : 15 - s; const float a = acc[idx >> 2][2 * d][idx & 3], bb = acc[idx >> 2][2 * d + 1][idx & 3]; Br = a * Br + bb; Ar *= a; }
                float Ac = 1.f, Bc = 0.f;
#pragma unroll
                for (int s = 0; s < 4; ++s) { const int f = d == 0 ? s : 3 - s; const float af = __shfl(Ar, fr + 16 * f), bf = __shfl(Br, fr + 16 * f); Bc = af * Bc + bf; Ac *= af; }
                if (fq == 0) { GAS float* ap = AGG + ((size_t)((b * NQ + q) * 2 + d) * 2) * 512 + c; ap[0] = Ac; ap[512] = Bc; }
            }
#pragma unroll
            for (int idx = 0; idx < 16; ++idx) *(GAS u32x2*)(AB + ((size_t)(r0 + 16 * fq + idx) * 512 + c) * 2) = abw[idx];
        }
        asm volatile("s_waitcnt lgkmcnt(0)" ::: "memory");
        local = queue_pull(qw, lane);
    }
    return local;
}
__device__ __forceinline__ void lru_scan(const Params& P, int l) {
    int tid = threadIdx.x; asm volatile("" : "+v"(tid)); const int c = tid;
    const GAS bf16_t* Z = (const GAS bf16_t*)(P.ws + OFF_Z); GAS bf16_t* Y = (GAS bf16_t*)(P.ws + OFF_Y);
    const GAS float* AGG = (const GAS float*)(P.ws + OFF_AGG); const GAS unsigned* AB = (const GAS unsigned*)(P.ws + OFF_AB);
    const int nitems = (l == 1) ? 512 : 544;
    for (int it = blockIdx.x; it < nitems; it += gridDim.x) {
        int b, j, q, r0seq;
        if (it < 512) { b = it >> 6; j = it & 63; q = 4 + j; r0seq = b * 4096; } else { const int t2 = it - 512; b = t2 >> 2; j = t2 & 3; q = j; r0seq = TL + b * 256; }
        const int r0 = r0seq + j * 64;
        float hin[2];
#pragma unroll
        for (int d = 0; d < 2; ++d) { const int rank = d == 0 ? q : (q < 4 ? 3 - q : 71 - q); float hh = 0.f;
#pragma unroll 1
            for (int r8 = 0; r8 < rank; r8 += 34) { float aa[34], bv[34];
#pragma unroll
                for (int k = 0; k < 34; ++k) { const int rho = r8 + k; const bool ok = rho < rank; const int rr = ok ? rho : 0; const int qq = d == 0 ? rr : (rr < 4 ? 3 - rr : 71 - rr);
                    const GAS float* ap = AGG + ((size_t)((b * NQ + qq) * 2 + d) * 2) * 512 + c; const float a0 = ap[0], b0 = ap[512]; aa[k] = ok ? a0 : 1.f; bv[k] = ok ? b0 : 0.f; }
#pragma unroll
                for (int k = 0; k < 34; ++k) hh = aa[k] * hh + bv[k]; }
            hin[d] = hh; }
        const GAS u32x2* abp = (const GAS u32x2*)(AB + ((size_t)r0 * 512 + c) * 2);
        u32x2 w[64];
#pragma unroll
        for (int p = 0; p < 64; ++p) w[p] = abp[(size_t)p * 512];
        float hf[64]; { float hh = hin[0];
#pragma unroll
            for (int p = 0; p < 64; ++p) { const float om = __uint_as_float(w[p].x << 16), bb = __uint_as_float(w[p].x & 0xffff0000u); hh = (hh - om * hh) + bb; hf[p] = hh; } }
        unsigned short gar[64];
#pragma unroll
        for (int p = 0; p < 64; ++p) gar[p] = Z[(size_t)(r0 + p) * ZW + 512 + c];
        { float hh = hin[1];
#pragma unroll
            for (int p = 63; p >= 0; --p) { const float om = __uint_as_float(w[p].y << 16), bb = __uint_as_float(w[p].y & 0xffff0000u); hh = (hh - om * hh) + bb;
                Y[(size_t)(r0 + p) * YW + c] = (bf16_t)f2bf((hf[p] + hh) * bf2f(gar[p])); } }
    }
}

#define XB_TMO      128
#define XB_XCNT(j)  (256  + 64 * (j))
#define XB_XSUB(j)  (1280 + 64 * (j))
#define XB_XGEN(j)  (2304 + 64 * (j))
#define XB_TOP      3328
#define XB_TOPGEN   3392
#define XCD_BAR_WORDS 3456
#define XB_SPIN_CAP (1u << 22)
__device__ __forceinline__ unsigned xb_ld(unsigned* p)              { return __hip_atomic_load(p, __ATOMIC_RELAXED, __HIP_MEMORY_SCOPE_AGENT); }
__device__ __forceinline__ unsigned xb_add(unsigned* p, unsigned v) { return __hip_atomic_fetch_add(p, v, __ATOMIC_RELAXED, __HIP_MEMORY_SCOPE_AGENT); }
__device__ __forceinline__ unsigned xb_xcc_id() { return (unsigned)__builtin_amdgcn_s_getreg((3 << 11) | 20) & 0xFu; }
#define XB_SPIN(cond, bar) do { unsigned _sp = 0; while (cond) { __builtin_amdgcn_s_sleep(1); \
    if ((++_sp & 255u) == 0u) { if (xb_ld(&(bar)[XB_TMO])) break; if (_sp > XB_SPIN_CAP) { atomicAdd(&(bar)[XB_TMO], 1u); break; } } } } while (0)
struct XcdBarrier { unsigned* bar; unsigned x; volatile LAS unsigned* st; };
__device__ __forceinline__ XcdBarrier xcd_barrier_post(unsigned* bar, volatile LAS unsigned* st) {
    XcdBarrier b; b.bar = bar; b.x = xb_xcc_id(); b.st = st;
    if (threadIdx.x == 0) (void)xb_add(&bar[XB_XCNT(b.x)], 1u);
    return b;
}
__device__ __forceinline__ void xcd_barrier_complete(unsigned* bar, unsigned x, unsigned& nloc, unsigned& nx) {
    const unsigned G = gridDim.x * gridDim.y * gridDim.z;
    unsigned sum, cnt, mine, sp = 0u;
    for (;;) {
        sum = 0u; cnt = 0u; mine = 0u;
#pragma unroll
        for (unsigned j = 0; j < 16; ++j) { const unsigned c = xb_ld(&bar[XB_XCNT(j)]); sum += c; cnt += (c > 0u) ? 1u : 0u; mine = (j == x) ? c : mine; }
        if (sum == G) break;
        __builtin_amdgcn_s_sleep(1);
        if ((++sp & 255u) == 0u) { if (xb_ld(&bar[XB_TMO])) break; if (sp > XB_SPIN_CAP) { atomicAdd(&bar[XB_TMO], 1u); break; } }
    }
    nloc = mine > 0u ? mine : 1u; nx = cnt > 0u ? cnt : 1u;
}
__device__ __forceinline__ void xcd_barrier(const XcdBarrier& b) {
    asm volatile("s_waitcnt vmcnt(0)" ::: "memory");
    __syncthreads();
    if (threadIdx.x == 0) {
        unsigned* bar = b.bar;
        __builtin_amdgcn_s_waitcnt(0);
        unsigned nloc = b.st[0], nx = b.st[1];
        if (nloc == 0u) { xcd_barrier_complete(bar, b.x, nloc, nx); b.st[0] = nloc; b.st[1] = nx; }
        const unsigned old = xb_add(&bar[XB_XSUB(b.x)], 1u);
        const unsigned gen = old / nloc;
        if (old + 1u == (gen + 1u) * nloc) {
            __builtin_amdgcn_fence(__ATOMIC_RELEASE, "agent");
            asm volatile("s_waitcnt vmcnt(0)" ::: "memory");
            const unsigned og = xb_add(&bar[XB_TOP], 1u);
            const unsigned tg = og / nx;
            if (og + 1u == (tg + 1u) * nx) xb_add(&bar[XB_TOPGEN], 1u);
            else XB_SPIN(xb_ld(&bar[XB_TOPGEN]) == tg, bar);
            __builtin_amdgcn_fence(__ATOMIC_ACQUIRE, "agent");
            xb_add(&bar[XB_XGEN(b.x)], 1u);
            asm volatile("s_waitcnt vmcnt(0)" ::: "memory");
        } else {
            XB_SPIN(xb_ld(&bar[XB_XGEN(b.x)]) == gen, bar);
            __builtin_amdgcn_fence(__ATOMIC_ACQUIRE, "agent");
            asm volatile("s_waitcnt vmcnt(0)" ::: "memory");
        }
    }
    __syncthreads();
}

__global__ void __launch_bounds__(512, 2) mega(Params P) {
    extern __shared__ __attribute__((aligned(16))) unsigned char lds_raw[];
    LAS unsigned char* lds = (LAS unsigned char*)lds_raw;
    cg::grid_group grid = cg::this_grid();
    unsigned char* ws = P.ws; const int G = gridDim.x, c = blockIdx.x;
    if (P.ph_lo < 0) grid.sync();
    volatile LAS unsigned* MISC = (volatile LAS unsigned*)(lds + 148480);
    if (threadIdx.x < 2) MISC[threadIdx.x] = 0u;
    __syncthreads();
    const XcdBarrier bar = xcd_barrier_post((unsigned*)(ws + OFF_BAR), MISC);
    int ph = 0;
#define RUN(...) do { if (ph >= P.ph_lo && ph < P.ph_hi) { __VA_ARGS__; if (ph + 1 < P.ph_hi) xcd_barrier(bar); } ++ph; } while (0)
    RUN(phase_prep(P, lds));
    RUN(phase_init(P));
    float* Hc = (float*)(ws + OFF_HC);
    for (int l = 0; l < 2; ++l) {
        const float* MODl = (const float*)(ws + OFF_MOD) + (size_t)l * 9 * 9216;
        for (int f = 0; f < 2; ++f) {
            if (f == 1) {
                RUN(phase_norm(P, l, 1, l == 1 ? 3 : 1));
                RUN({ InOrder S{(const char*)(ws + OFF_XN), (const char*)(ws + OFF_WIN + l * SZ_WIN1), G, c};
                      EpiIn E{(bf16_t*)(ws + OFF_Z), (bf16_t*)(ws + OFF_VT), (bf16_t*)(ws + OFF_VTC), (bf16_t*)(ws + OFF_FT), (bf16_t*)(ws + OFF_FTC)};
                      gemm_phase(lds, 1024, S, E); });
                RUN({ { DftOrder S{(const char*)(ws + OFF_DFTM), (const char*)(ws + OFF_FT), G, c}; EpiDft E{(bf16_t*)(ws + OFF_Y)}; gemm_phase(lds, 4096, S, E); }
                      if (l == 0) { DftCOrder S{(const char*)(ws + OFF_DFTMC), (const char*)(ws + OFF_FTC), G, c}; EpiDft E{(bf16_t*)(ws + OFF_Y)}; gemm_phase(lds, 256, S, E); }
                      __syncthreads();
                      dft_nyquist(P);
                      { unsigned* q = (unsigned*)(ws + OFF_BAR) + XCD_BAR_WORDS + 16 * (8 * l + (c & 7));
                        const int lg = lru_pass1(P, l, lds, q); gmlp_items(P, l, lg, q); } });
                RUN(lru_scan(P, l));
                RUN({ SplitOrder S{(const char*)(ws + OFF_Y), (const char*)(ws + OFF_WOUT + l * SZ_WOUT1), l == 1 ? 0 : 2, G, c, (size_t)256 * 1280 * 2, 20};
                      EpiRes E{P.out, Hc, MODl + 5 * 1024, (float*)(ws + OFF_PART), 1.0f, 0}; gemm_phase(lds, 1280, S, E); });
                RUN(phase_norm(P, l, 2, l == 0 ? 3 : 0));
            }
            RUN({ StaticOrder S{(const char*)(ws + OFF_XN), (const char*)(ws + OFF_WGU + (l * 2 + f) * SZ_WGU1), (l == 1 && f == 1) ? 128 : NPAN, 22, G, c, (size_t)256 * 1024 * 2, 16};
                  EpiGU E{(bf16_t*)(ws + OFF_ACT)}; gemm_phase(lds, 1024, S, E); });
            RUN({ SplitOrder S{(const char*)(ws + OFF_ACT), (const char*)(ws + OFF_WDN + (l * 2 + f) * SZ_WDN1), (l == 1 && f == 1) ? 0 : (l == 1 ? 2 : 1), G, c, (size_t)256 * DFF * 2, 44};
                  EpiRes E{P.out, Hc, MODl + (f == 0 ? 2 : 8) * 1024, (float*)(ws + OFF_PART), 0.5f, 0}; gemm_phase(lds, DFF, S, E);
                  if (l == 0 && c >= 64) { if (f == 0) { prep_dft(P, lds, c - 64, 192); prep_weights(P, lds, 0, c - 64, 192, 0x7f & ~(1 | 4)); } else prep_weights(P, lds, 1, c - 64, 192, 0x7f); } });
        }
        if (l == 0) RUN(phase_norm(P, 1, 0, 1)); else RUN(phase_final(P));
    }
#undef RUN
#ifdef PROBE
    xcd_barrier(bar);
#if PROBE == 1
    for (int i = 0; i < 40; ++i) xcd_barrier(bar);
#elif PROBE == 2
    for (int i = 0; i < 3; ++i) { gmlp_items(P, 1); lru_pass1(P, 1, lds); xcd_barrier(bar); lru_scan(P, 1); xcd_barrier(bar); }
#elif PROBE == 3
    for (int i = 0; i < 2; ++i) { phase_prep(P, lds); xcd_barrier(bar); }
#endif
#endif
}
constexpr int N_PHASES = 2 + 2 * 11;

extern "C" void kernel_launch(void* const* d_in, const int* in_sizes, int n_in, void* d_out, int out_size, void* d_ws, size_t ws_size, hipStream_t stream) {
    static int grid = 0;
    if (grid == 0) {
        if (n_in != 19 || out_size != TL * D || ws_size < WS_END) { fprintf(stderr, "kernel_launch: unexpected shapes (n_in %d out %d ws %zu need %zu)\n", n_in, out_size, ws_size, (size_t)WS_END); grid = -1; return; }
        int dev = 0, cus = 0, per_cu = 0;
        hipGetDevice(&dev); hipDeviceGetAttribute(&cus, hipDeviceAttributeMultiprocessorCount, dev);
        if (hipFuncSetAttribute((const void*)mega, hipFuncAttributeMaxDynamicSharedMemorySize, LDS_BYTES) != hipSuccess) { fprintf(stderr, "kernel_launch: hipFuncSetAttribute failed\n"); grid = -1; return; }
        hipOccupancyMaxActiveBlocksPerMultiprocessor(&per_cu, (const void*)mega, 512, LDS_BYTES);
        (void)hipGetLastError();
        if (per_cu < 1) per_cu = 1;
        grid = cus;
    }
    if (grid < 0) return;
    Params p{};
    p.x = (const float*)d_in[0]; p.c = (const float*)d_in[1]; p.ctx = (const float*)d_in[2]; p.c_ctx = (const float*)d_in[3]; p.w_mod = (const float*)d_in[4]; p.b_mod = (const float*)d_in[5];
    p.norm_g = (const float*)d_in[6]; p.w_gu = (const float*)d_in[7]; p.w_down = (const float*)d_in[8]; p.w_in = (const float*)d_in[9]; p.w_out = (const float*)d_in[10];
    p.conv_w = (const float*)d_in[11]; p.conv_b = (const float*)d_in[12]; p.lru_wg = (const float*)d_in[13]; p.lru_bg = (const float*)d_in[14]; p.lru_lam = (const float*)d_in[15];
    p.gmlp_ws = (const float*)d_in[16]; p.gmlp_bs = (const float*)d_in[17]; p.final_g = (const float*)d_in[18];
    p.out = (float*)d_out; p.ws = (unsigned char*)d_ws; p.ph_lo = 0; p.ph_hi = N_PHASES;
    if (hipMemsetAsync((char*)d_ws + OFF_BAR, 0, 16384, stream) != hipSuccess) { fprintf(stderr, "kernel_launch: hipMemsetAsync failed\n"); return; }
    void* args[] = {&p};
    hipError_t e = hipLaunchCooperativeKernel((const void*)mega, dim3(grid), dim3(512), args, LDS_BYTES, stream);
    if (e != hipSuccess) fprintf(stderr, "kernel_launch: cooperative launch failed: %s (grid %d)\n", hipGetErrorString(e), grid);
}
```

```cpp
#include <hip/hip_runtime.h>
#include <hip/hip_cooperative_groups.h>
#include <cstdio>
#include <cstdint>
namespace cg = cooperative_groups;

#define LAS __attribute__((address_space(3)))
#define GAS __attribute__((address_space(1)))
typedef unsigned short bf16_t;
typedef short bf16x8 __attribute__((ext_vector_type(8)));
typedef float f32x4 __attribute__((ext_vector_type(4)));
typedef float f32x2 __attribute__((ext_vector_type(2)));
typedef unsigned u32x4 __attribute__((ext_vector_type(4)));
typedef unsigned u32x2 __attribute__((ext_vector_type(2)));

constexpr int D = 1024, NB = 8, SEQ = 4096, CTXL = 256, TL = NB * SEQ, TC = NB * CTXL, T = TL + TC, NPAN = T / 256;
constexpr int DFF = 2816, ZW = 1280, YW = 1280, NMOD = 9;
constexpr int NQ = 68;

constexpr size_t SZ_WGU1 = (size_t)5632 * 1024 * 2, SZ_WDN1 = (size_t)1024 * 2816 * 2, SZ_WIN1 = (size_t)1792 * 1024 * 2, SZ_WOUT1 = (size_t)1024 * 1280 * 2;
constexpr size_t SZ_WGT1 = 131072 * 2, SZ_GWS1 = 65536 * 2;
constexpr size_t OFF_WGU = 0;
constexpr size_t OFF_WDN = OFF_WGU + 4 * SZ_WGU1;
constexpr size_t OFF_WIN = OFF_WDN + 4 * SZ_WDN1;
constexpr size_t OFF_WOUT = OFF_WIN + 2 * SZ_WIN1;
constexpr size_t OFF_WGT = OFF_WOUT + 2 * SZ_WOUT1;
constexpr size_t OFF_GWS = OFF_WGT + 2 * SZ_WGT1;
constexpr size_t OFF_MOD = OFF_GWS + 2 * SZ_GWS1;
constexpr size_t OFF_DFTM = OFF_MOD + (size_t)2 * 9 * 9216 * 4;
constexpr size_t OFF_DFTMC = OFF_DFTM + (size_t)8192 * 4096 * 2;
constexpr size_t OFF_HC = OFF_DFTMC + (size_t)512 * 256 * 2;
constexpr size_t OFF_XN = OFF_HC + (size_t)TC * 1024 * 4;
constexpr size_t OFF_AB = OFF_XN;
constexpr size_t OFF_AGG = OFF_AB + (size_t)T * 512 * 2 * 4;
constexpr size_t OFF_SP8 = OFF_AGG + (size_t)NB * NQ * 2 * 2 * 512 * 4;
constexpr size_t OFF_BAR = OFF_SP8 + 8192;
constexpr size_t OFF_PART = OFF_BAR + 16384;
constexpr size_t OFF_U = OFF_PART + (size_t)TC * 1024 * 4;
constexpr size_t OFF_ACT = OFF_U;
constexpr size_t OFF_Z = OFF_U;
constexpr size_t OFF_Y = OFF_Z + (size_t)T * ZW * 2;
constexpr size_t OFF_VT = OFF_Y + (size_t)T * YW * 2;
constexpr size_t OFF_VTC = OFF_VT + (size_t)NB * 256 * 4096 * 2;
constexpr size_t OFF_FT = OFF_VTC + (size_t)NB * 256 * 256 * 2;
constexpr size_t OFF_FTC = OFF_FT + (size_t)NB * 256 * 4096 * 2;
constexpr size_t U_END1 = OFF_FTC + (size_t)NB * 256 * 256 * 2;
constexpr size_t OFF_PART2 = OFF_FT;
constexpr size_t OFF_PART3 = OFF_FT + (size_t)TC * 1024 * 4;
static_assert(OFF_FT >= OFF_ACT + (size_t)T * DFF * 2 && OFF_PART3 + (size_t)TC * 1024 * 4 <= U_END1, "partial buffers must lie beyond ACT inside the FT region");
constexpr size_t U_END2 = OFF_ACT + (size_t)T * DFF * 2;
constexpr size_t WS_END = U_END1 > U_END2 ? U_END1 : U_END2;

constexpr int LDS_BYTES = 151552;

struct Params {
    const float *x, *c, *ctx, *c_ctx, *w_mod, *b_mod, *norm_g, *w_gu, *w_down, *w_in, *w_out, *conv_w, *conv_b, *lru_wg, *lru_bg, *lru_lam, *gmlp_ws, *gmlp_bs, *final_g;
    float* out; unsigned char* ws; int ph_lo, ph_hi;
};

__device__ __forceinline__ float bf2f(unsigned short b) { return __uint_as_float(((unsigned)b) << 16); }
__device__ __forceinline__ unsigned f2bf(float f) { unsigned u = __float_as_uint(f); return (u + 0x7fffu + ((u >> 16) & 1u)) >> 16; }
__device__ __forceinline__ unsigned cvt_pk_bf16(float lo, float hi) { unsigned r; asm volatile("v_cvt_pk_bf16_f32 %0, %1, %2" : "=v"(r) : "v"(lo), "v"(hi)); return r; }
__device__ __forceinline__ float wave_sum(float v) {
#pragma unroll
    for (int o = 1; o < 64; o <<= 1) v += __shfl_xor(v, o);
    return v;
}
__device__ __forceinline__ float silu_f(float g) { return g * __builtin_amdgcn_rcpf(1.0f + __expf(-g)); }
__device__ __forceinline__ float gelu_tanh_f(float x) { const float u = 1.5957691216f * (x + 0.044715f * x * x * x); return x * __builtin_amdgcn_rcpf(1.0f + __expf(-u)); }
__device__ __forceinline__ float sigmoid_fast(float x) { return __builtin_amdgcn_rcpf(1.0f + __expf(-x)); }

constexpr int BM = 256, BK = 64, HALF = 128, HTB = HALF * BK * 2, NXCD = 8, WGM = 8;
__device__ __forceinline__ int lds_byte(int r, int c) { const int st = (r >> 4) * 2 + (c >> 5), rr = r & 15, cc = c & 31, ob = rr * 64 + cc * 2; return st * 1024 + (ob ^ (((ob >> 9) & 1) << 5)); }
__device__ __forceinline__ void stage_rc(int b, int& R, int& C) { const int st = b / 1024, sb = b % 1024, swz = sb ^ (((sb >> 9) & 1) << 5); R = (st >> 1) * 16 + swz / 64; C = (st & 1) * 32 + (swz % 64) / 2; }
__device__ __forceinline__ int perm32(int rho) { const int n = rho >> 4, i = rho & 15; return 8 * (i >> 2) + 4 * n + (i & 3); }

struct Unit { const char* a; const char* b; int pm, pn, kind, pad; };

__device__ __forceinline__ bool tile_map(long L, int nM, int nN, int& pm, int& pn) {
    const int nwg = nM * nN; if (L >= nwg) return false;
    int wgid = (int)L; { const int q = nwg / NXCD, r = nwg % NXCD, xcd = wgid % NXCD, off = wgid / NXCD; wgid = (xcd < r ? xcd * (q + 1) : r * (q + 1) + (xcd - r) * q) + off; }
    const int nig = WGM * nN, gid = wgid / nig, fm = gid * WGM, gsz = (nM - fm) < WGM ? (nM - fm) : WGM;
    pm = fm + ((wgid % nig) % gsz); pn = (wgid % nig) / gsz; return true;
}
struct StaticOrder {
    const char* A; const char* Bt; int nM, nN, G, c; size_t tstep; int nt;
    __device__ __forceinline__ bool next(int i, Unit& u) const {
        int pm, pn; if (!tile_map((long)i * G + c, nM, nN, pm, pn)) return false;
        u.a = A + (size_t)pm * tstep; u.b = Bt + (size_t)pn * tstep; u.pm = pm; u.pn = pn; u.kind = 0; u.pad = nt; return true;
    }
};
struct SplitOrder {
    const char* A; const char* Bt; int ctx, G, c; size_t tstep; int nt;
    __device__ __forceinline__ bool next(int i, Unit& u) const {
        const int L = i * G + c;
        if (L < 512) { int pm, pn; tile_map(L, 128, 4, pm, pn); u.a = A + (size_t)pm * tstep; u.b = Bt + (size_t)pn * tstep; u.pm = pm; u.pn = pn; u.kind = 0; u.pad = nt; return true; }
        const int sidx = L - 512; if (sidx >= 64 * ctx) return false;
        int id, ks, t0, un;
        if (ctx == 1) { id = sidx >> 1; ks = sidx & 1; un = nt >> 1; t0 = ks * un; }
        else { id = sidx >> 2; ks = sidx & 3; const int qa = ((nt >> 2) + 1) & ~1, qb = (nt >> 1) - qa;
            t0 = ks == 0 ? 0 : ks == 1 ? qa : ks == 2 ? 2 * qa : 2 * qa + qb; un = ks < 2 ? qa : qb; }
        const int pm = 128 + (id >> 2), pn = id & 3; const size_t koff = (size_t)t0 * 128;
        u.a = A + (size_t)pm * tstep + koff; u.b = Bt + (size_t)pn * tstep + koff; u.pm = pm; u.pn = pn; u.kind = 1 + ks; u.pad = un; return true;
    }
};
struct InOrder {
    const char* XN; const char* W; int G, c;
    __device__ __forceinline__ bool next(int i, Unit& u) const {
        const size_t tstep = (size_t)256 * 1024 * 2; const long L = (long)i * G + c;
        if (L < NPAN * 5) { int pm, pn; tile_map(L, NPAN, 5, pm, pn); u.a = XN + (size_t)pm * tstep; u.b = W + (size_t)pn * tstep; u.pm = pm; u.pn = pn; u.kind = 0; u.pad = 16; return true; }
        const long L2 = L - NPAN * 5; if (L2 >= NPAN * 2) return false;
        const int which = (int)(L2 & 1), pnn = (int)(L2 >> 1);
        u.a = W + (size_t)(5 + which) * tstep; u.b = XN + (size_t)pnn * tstep; u.pm = which; u.pn = pnn; u.kind = 1; u.pad = 16; return true;
    }
};
struct DftOrder {
    const char* A; const char* FT; int G, c;
    __device__ __forceinline__ bool next(int i, Unit& u) const {
        if (i != 0 || c >= 128) return false;
        const int x = c & 7, qq = c >> 3, pi = 2 * x + (qq & 1), pm2 = pi < 8 ? pi : pi + 8, b = qq >> 1; const size_t tstep = (size_t)256 * 4096 * 2;
        u.a = A + (size_t)pm2 * tstep; u.b = FT + (size_t)b * tstep; u.pm = pm2; u.pn = b; u.kind = 0; u.pad = 64; return true;
    }
};
struct DftCOrder {
    const char* A; const char* FT; int G, c;
    __device__ __forceinline__ bool next(int i, Unit& u) const {
        const long L = (long)i * G + c; if (L >= 16) return false;
        const int pm2 = (int)(L & 1), b = (int)(L >> 1); const size_t tstep = (size_t)256 * 256 * 2;
        u.a = A + (size_t)pm2 * tstep; u.b = FT + (size_t)b * tstep; u.pm = pm2; u.pn = b; u.kind = 1; u.pad = 4; return true;
    }
};

__device__ __forceinline__ void store_bf16_tile(const f32x4 (&acc)[2][2][4][2], GAS bf16_t* p0, size_t ld, bool act, float scale) {
#pragma unroll
    for (int ai = 0; ai < 2; ++ai)
#pragma unroll
        for (int m = 0; m < 4; ++m) { GAS bf16_t* rowp = p0 + (size_t)(ai * HALF + m * 16) * ld;
#pragma unroll
            for (int bj = 0; bj < 2; ++bj) { f32x4 v0 = acc[ai][bj][m][0] * scale, v1 = acc[ai][bj][m][1] * scale;
                if (act) {
#pragma unroll
                    for (int hj = 0; hj < 2; ++hj) { const f32x2 xa = (f32x2){v0[2 * hj], v0[2 * hj + 1]}, xb = (f32x2){v1[2 * hj], v1[2 * hj + 1]};
                        const f32x2 ta = xa * ((xa * xa) * (-0.10294324f) + (-2.302208198f)), tb = xb * ((xb * xb) * (-0.10294324f) + (-2.302208198f));
                        const f32x2 da = (f32x2){__builtin_amdgcn_exp2f(ta.x), __builtin_amdgcn_exp2f(ta.y)} + 1.0f, db = (f32x2){__builtin_amdgcn_exp2f(tb.x), __builtin_amdgcn_exp2f(tb.y)} + 1.0f;
                        const f32x2 ra = xa * (f32x2){__builtin_amdgcn_rcpf(da.x), __builtin_amdgcn_rcpf(da.y)}, rb = xb * (f32x2){__builtin_amdgcn_rcpf(db.x), __builtin_amdgcn_rcpf(db.y)};
                        v0[2 * hj] = ra.x; v0[2 * hj + 1] = ra.y; v1[2 * hj] = rb.x; v1[2 * hj + 1] = rb.y; } }
                u32x4 w; w.x = cvt_pk_bf16(v0[0], v0[1]); w.y = cvt_pk_bf16(v0[2], v0[3]); w.z = cvt_pk_bf16(v1[0], v1[1]); w.w = cvt_pk_bf16(v1[2], v1[3]);
                *(GAS u32x4*)(rowp + bj * HALF) = w; } }
}
struct EpiGU {
    static constexpr bool PERM = true; bf16_t* ACT;
    __device__ __forceinline__ void operator()(const f32x4 (&acc)[2][2][4][2], const Unit& u, int wr, int wc, int fr, int fq) const {
        GAS bf16_t* p0 = (GAS bf16_t*)ACT + (size_t)(u.pm * BM + wr * 64 + fr) * DFF + u.pn * 128 + wc * 32 + 8 * fq;
#pragma unroll
        for (int ai = 0; ai < 2; ++ai)
#pragma unroll
            for (int m = 0; m < 4; ++m) { GAS bf16_t* rowp = p0 + (size_t)(ai * HALF + m * 16) * DFF;
                const f32x4 g0 = acc[ai][0][m][0], g1 = acc[ai][0][m][1], u0 = acc[ai][1][m][0], u1 = acc[ai][1][m][1]; f32x4 v0, v1;
#pragma unroll
                for (int hj = 0; hj < 2; ++hj) {
                    const f32x2 ga = (f32x2){g0[2 * hj], g0[2 * hj + 1]}, gb = (f32x2){g1[2 * hj], g1[2 * hj + 1]}, ua = (f32x2){u0[2 * hj], u0[2 * hj + 1]}, ub = (f32x2){u1[2 * hj], u1[2 * hj + 1]};
                    const f32x2 ta = ga * (-1.4426950408889634f), tb = gb * (-1.4426950408889634f);
                    const f32x2 da = (f32x2){__builtin_amdgcn_exp2f(ta.x), __builtin_amdgcn_exp2f(ta.y)} + 1.0f, db = (f32x2){__builtin_amdgcn_exp2f(tb.x), __builtin_amdgcn_exp2f(tb.y)} + 1.0f;
                    const f32x2 ra = (ga * ua) * (f32x2){__builtin_amdgcn_rcpf(da.x), __builtin_amdgcn_rcpf(da.y)}, rb = (gb * ub) * (f32x2){__builtin_amdgcn_rcpf(db.x), __builtin_amdgcn_rcpf(db.y)};
                    v0[2 * hj] = ra.x; v0[2 * hj + 1] = ra.y; v1[2 * hj] = rb.x; v1[2 * hj + 1] = rb.y; }
                u32x4 w; w.x = cvt_pk_bf16(v0[0], v0[1]); w.y = cvt_pk_bf16(v0[2], v0[3]); w.z = cvt_pk_bf16(v1[0], v1[1]); w.w = cvt_pk_bf16(v1[2], v1[3]);
                *(GAS u32x4*)rowp = w; }
    }
};
struct EpiRes {
    static constexpr bool PERM = false; float* Hl; float* Hc; const float* gate; float* PART; float mul; int padm;
    __device__ __forceinline__ void operator()(const f32x4 (&acc)[2][2][4][2], const Unit& u, int wr, int wc, int fr, int fq) const {
        const int vb = u.pm < 128 ? (u.pm >> 4) : 8;
        GAS float* base = (GAS float*)(u.pm < 128 ? Hl + (size_t)u.pm * 256 * 1024 : (u.kind >= 2 ? PART + (u.kind == 3 ? (size_t)((OFF_PART2 - OFF_PART) / 4) : u.kind == 4 ? (size_t)((OFF_PART3 - OFF_PART) / 4) : (size_t)0) : Hc) + (size_t)(u.pm - 128) * 256 * 1024);
        const int col0 = u.pn * BM + wc * 32 + 4 * fq; const GAS float* gp = (const GAS float*)gate + vb * 9216 + col0;
        GAS float* row0 = base + (size_t)(wr * 64 + fr) * 1024 + col0;
        if (u.kind >= 2) {
#pragma unroll
            for (int bj = 0; bj < 2; ++bj)
#pragma unroll
                for (int n = 0; n < 2; ++n) { const f32x4 gv = *(const GAS f32x4*)(gp + bj * HALF + n * 16) * mul;
#pragma unroll
                    for (int ai = 0; ai < 2; ++ai)
#pragma unroll
                        for (int m = 0; m < 4; ++m) *(GAS f32x4*)(row0 + (size_t)(ai * HALF + m * 16) * 1024 + bj * HALF + n * 16) = gv * acc[ai][bj][m][n]; }
            return; }
#pragma unroll
        for (int bj = 0; bj < 2; ++bj) {
            f32x4 hv[2][2][4];
#pragma unroll
            for (int n = 0; n < 2; ++n)
#pragma unroll
                for (int ai = 0; ai < 2; ++ai)
#pragma unroll
                    for (int m = 0; m < 4; ++m) hv[n][ai][m] = *(const GAS f32x4*)(row0 + (size_t)(ai * HALF + m * 16) * 1024 + bj * HALF + n * 16);
            asm volatile("" ::: "memory");
#pragma unroll
            for (int n = 0; n < 2; ++n) { const f32x4 gv = *(const GAS f32x4*)(gp + bj * HALF + n * 16) * mul;
#pragma unroll
                for (int ai = 0; ai < 2; ++ai)
#pragma unroll
                    for (int m = 0; m < 4; ++m) *(GAS f32x4*)(row0 + (size_t)(ai * HALF + m * 16) * 1024 + bj * HALF + n * 16) = hv[n][ai][m] + gv * acc[ai][bj][m][n]; }
            asm volatile("" ::: "memory"); }
    }
};
struct EpiIn {
    static constexpr bool PERM = true; bf16_t *Z, *VT, *VTC, *FT, *FTC;
    __device__ __forceinline__ void operator()(const f32x4 (&acc)[2][2][4][2], const Unit& u, int wr, int wc, int fr, int fq) const {
        GAS bf16_t* p0; size_t ld; bool act;
        if (u.kind == 0) { p0 = (GAS bf16_t*)Z + (size_t)(u.pm * BM + wr * 64 + fr) * ZW + u.pn * BM + wc * 32 + 8 * fq; ld = ZW; act = u.pn >= 2; }
        else { const int which = u.pm, pnn = u.pn; act = (which == 0);
            if (pnn < 128) { const int bb = pnn >> 4, n0 = (pnn & 15) * 256; ld = 4096; p0 = (GAS bf16_t*)(which ? FT : VT) + ((size_t)bb * 256 + wr * 64 + fr) * 4096 + n0 + wc * 32 + 8 * fq; }
            else { const int bb = pnn - 128; ld = 256; p0 = (GAS bf16_t*)(which ? FTC : VTC) + ((size_t)bb * 256 + wr * 64 + fr) * 256 + wc * 32 + 8 * fq; } }
        store_bf16_tile(acc, p0, ld, act, 1.0f);
    }
};
struct EpiDft {
    static constexpr bool PERM = true; bf16_t* Y;
    __device__ __forceinline__ void operator()(const f32x4 (&acc)[2][2][4][2], const Unit& u, int wr, int wc, int fr, int fq) const {
        if (u.kind == 0) {
            const int k0 = (u.pm & 15) * 256 + wr * 64 + fr, colbase = 768 + 256 * (u.pm >> 4); const unsigned flip = (u.pm >> 4) ? 0x80008000u : 0u; const float scale = 1.0f / 512.0f;
            GAS bf16_t* yb = (GAS bf16_t*)Y + (size_t)u.pn * 4096 * YW + colbase + wc * 32 + 8 * fq;
#pragma unroll
            for (int ai = 0; ai < 2; ++ai)
#pragma unroll
                for (int m = 0; m < 4; ++m) { const int k = k0 + ai * HALF + m * 16;
#pragma unroll
                    for (int bj = 0; bj < 2; ++bj) { const f32x4 v0 = acc[ai][bj][m][0] * scale, v1 = acc[ai][bj][m][1] * scale;
                        u32x4 w; w.x = cvt_pk_bf16(v0[0], v0[1]); w.y = cvt_pk_bf16(v0[2], v0[3]); w.z = cvt_pk_bf16(v1[0], v1[1]); w.w = cvt_pk_bf16(v1[2], v1[3]);
                        *(GAS u32x4*)(yb + (size_t)k * YW + bj * HALF) = w;
                        if (k != 0) { u32x4 wm; wm.x = w.x ^ flip; wm.y = w.y ^ flip; wm.z = w.z ^ flip; wm.w = w.w ^ flip; *(GAS u32x4*)(yb + (size_t)(4096 - k) * YW + bj * HALF) = wm; } } }
        } else {
            GAS bf16_t* p0 = (GAS bf16_t*)Y + (size_t)(TL + u.pn * 256 + wr * 64 + fr) * YW + 768 + 256 * u.pm + wc * 32 + 8 * fq;
            store_bf16_tile(acc, p0, YW, false, 1.0f / 128.0f);
        }
    }
};

template <class Epi, class Sched>
__device__ __forceinline__ void gemm_phase(LAS unsigned char* lds, const int K, const Sched& S, const Epi& E) {
    int tid = threadIdx.x; asm volatile("" : "+v"(tid));
    const int wid = __builtin_amdgcn_readfirstlane(tid >> 6), lane = tid & 63, wr = wid >> 2, wc = wid & 3, fr = lane & 15, fq = lane >> 4;
    unsigned voffA[2], voffB[2];
#pragma unroll
    for (int i = 0; i < 2; ++i) { int R, C; stage_rc(tid * 16 + i * 8192, R, C); const int Rb = Epi::PERM ? ((R & ~31) + perm32(R & 31)) : R;
        voffA[i] = (unsigned)(R * K + C) * 2u; voffB[i] = (unsigned)(Rb * K + C) * 2u; }
    const size_t kstep = (size_t)(BK * 2);
    const size_t hstep = (size_t)HALF * K * 2;
    const unsigned ldsw = (unsigned)wid * 1024u;
    const int aoff = lds_byte(wr * 64 + fr, fq * 8), boff = lds_byte(wc * 32 + fr, fq * 8);
#define PG8_SA(b, h) (((b) * 2 + (h)) * HTB)
#define PG8_SB(b, h) ((4 + (b) * 2 + (h)) * HTB)
#define PG8_STAGE(bufoff, gbase, voff) do { _Pragma("unroll") for (int _i = 0; _i < 2; ++_i) \
        __builtin_amdgcn_global_load_lds((const unsigned*)((const char*)(gbase) + (voff)[_i]), (LAS unsigned*)(lds + (bufoff) + ldsw + _i * 8192), 16, 0, 0); } while (0)
#define PG8_LDA(dst, b, h) do { _Pragma("unroll") for (int m = 0; m < 4; ++m) _Pragma("unroll") for (int k = 0; k < 2; ++k) dst[m][k] = *(const LAS bf16x8*)(lds + PG8_SA(b, h) + aoff + m * 2048 + k * 1024); } while (0)
#define PG8_LDB(dst, b, h) do { _Pragma("unroll") for (int n = 0; n < 2; ++n) _Pragma("unroll") for (int k = 0; k < 2; ++k) dst[n][k] = *(const LAS bf16x8*)(lds + PG8_SB(b, h) + boff + n * 2048 + k * 1024); } while (0)
#define PG8_MMA(ai, bj, At, Bt) do { __builtin_amdgcn_s_setprio(1); _Pragma("unroll") for (int m = 0; m < 4; ++m) _Pragma("unroll") for (int n = 0; n < 2; ++n) _Pragma("unroll") for (int k = 0; k < 2; ++k) \
        acc[ai][bj][m][n] = __builtin_amdgcn_mfma_f32_16x16x32_bf16(Bt[n][k], At[m][k], acc[ai][bj][m][n], 0, 0, 0); __builtin_amdgcn_s_setprio(0); } while (0)
#define PG8_WAIT_V(n) asm volatile("s_waitcnt vmcnt(" #n ")" ::: "memory")
#define PG8_WAIT_L(n) asm volatile("s_waitcnt lgkmcnt(" #n ")" ::: "memory")
#define PG8_BAR __builtin_amdgcn_s_barrier()
#define PG8_SCHED __builtin_amdgcn_sched_barrier(0)
    Unit cur, nxt; int ui = 0;
    if (!S.next(0, cur)) return;
    f32x4 acc[2][2][4][2];
#pragma unroll
    for (int a = 0; a < 2; ++a)
#pragma unroll
        for (int b = 0; b < 2; ++b)
#pragma unroll
            for (int m = 0; m < 4; ++m)
#pragma unroll
                for (int n = 0; n < 2; ++n) acc[a][b][m][n] = (f32x4){0.f, 0.f, 0.f, 0.f};
    bf16x8 At[4][2], B0[2][2], B1[2][2];
    const char* cA = cur.a; const char* cB = cur.b;
    PG8_STAGE(PG8_SB(0, 0), cB, voffB); PG8_STAGE(PG8_SB(0, 1), cB + hstep, voffB); PG8_STAGE(PG8_SA(0, 0), cA, voffA); PG8_STAGE(PG8_SA(0, 1), cA + hstep, voffA);
    if (wr == 1) PG8_BAR;
    PG8_WAIT_V(2); PG8_BAR;
    PG8_STAGE(PG8_SB(1, 0), cB + kstep, voffB); PG8_STAGE(PG8_SA(1, 0), cA + kstep, voffA); PG8_STAGE(PG8_SB(1, 1), cB + hstep + kstep, voffB);
    PG8_WAIT_V(6); PG8_BAR;
    for (;;) {
        const bool has_next = S.next(ui + 1, nxt);
        const char* nA = has_next ? nxt.a : cA; const char* nB = has_next ? nxt.b : cB;
        const int nt = cur.pad;
#pragma unroll 1
        for (int t = 0; t < nt; t += 2) {
            const bool last = (t == nt - 2);
            const char* a1 = cA + (size_t)(t + 1) * kstep;
            const char* a2 = last ? nA : cA + (size_t)(t + 2) * kstep; const char* b2 = last ? nB : cB + (size_t)(t + 2) * kstep;
            const char* a3 = a2 + kstep; const char* b3 = b2 + kstep;
            PG8_LDB(B0, 0, 0); PG8_LDB(B1, 0, 1); PG8_SCHED; PG8_LDA(At, 0, 0); PG8_STAGE(PG8_SA(1, 1), a1 + hstep, voffA);
            PG8_WAIT_V(8); PG8_WAIT_L(0); PG8_BAR; PG8_MMA(0, 0, At, B0); PG8_MMA(0, 1, At, B1); PG8_BAR; PG8_SCHED;
            PG8_LDA(At, 0, 1); PG8_STAGE(PG8_SB(0, 0), b2, voffB); PG8_STAGE(PG8_SB(0, 1), b2 + hstep, voffB); PG8_STAGE(PG8_SA(0, 0), a2, voffA);
            PG8_WAIT_V(8); PG8_WAIT_L(0); PG8_BAR; PG8_MMA(1, 0, At, B0); PG8_MMA(1, 1, At, B1); PG8_BAR; PG8_SCHED;
            PG8_LDB(B0, 1, 0); PG8_LDB(B1, 1, 1); PG8_SCHED; PG8_LDA(At, 1, 0); PG8_STAGE(PG8_SA(0, 1), a2 + hstep, voffA);
            PG8_WAIT_V(8); PG8_WAIT_L(0); PG8_BAR; PG8_MMA(0, 0, At, B0); PG8_MMA(0, 1, At, B1); PG8_BAR; PG8_SCHED;
            PG8_LDA(At, 1, 1); PG8_STAGE(PG8_SB(1, 0), b3, voffB); PG8_STAGE(PG8_SB(1, 1), b3 + hstep, voffB); PG8_STAGE(PG8_SA(1, 0), a3, voffA);
            PG8_WAIT_V(8); PG8_WAIT_L(0); PG8_BAR; PG8_MMA(1, 0, At, B0); PG8_MMA(1, 1, At, B1); PG8_BAR; PG8_SCHED;
        }
        if (wr == 0) PG8_BAR;
        E(acc, cur, wr, wc, fr, fq);
        if (!has_next) break;
#pragma unroll
        for (int a = 0; a < 2; ++a)
#pragma unroll
            for (int b = 0; b < 2; ++b)
#pragma unroll
                for (int m = 0; m < 4; ++m)
#pragma unroll
                    for (int n = 0; n < 2; ++n) acc[a][b][m][n] = (f32x4){0.f, 0.f, 0.f, 0.f};
        cur = nxt; cA = nA; cB = nB; ++ui;
        if (wr == 1) PG8_BAR;
    }
    PG8_WAIT_V(0);
    PG8_BAR;
#undef PG8_SA
#undef PG8_SB
#undef PG8_STAGE
#undef PG8_LDA
#undef PG8_LDB
#undef PG8_MMA
#undef PG8_WAIT_V
#undef PG8_WAIT_L
#undef PG8_BAR
#undef PG8_SCHED
}

__device__ __forceinline__ void transpose_item(const float* W, int ldw, int k0, int n0, bf16_t* WT, int ldt, int drow0, int dk0, LAS float* scr, int lane) {
    float tv[32];
#pragma unroll
    for (int i = 0; i < 32; ++i) { const int kk = 2 * i + (lane >> 5); tv[i] = W[(size_t)(k0 + kk) * ldw + n0 + (lane & 31)]; }
#pragma unroll
    for (int i = 0; i < 32; ++i) { const int kk = 2 * i + (lane >> 5); scr[kk * 33 + (lane & 31)] = tv[i]; }
    asm volatile("s_waitcnt lgkmcnt(0)" ::: "memory");
    const int c = lane & 7;
#pragma unroll
    for (int j = 0; j < 4; ++j) { const int n = (lane >> 3) + 8 * j; const LAS float* s = scr + (8 * c) * 33 + n;
        u32x4 o; o.x = cvt_pk_bf16(s[0 * 33], s[1 * 33]); o.y = cvt_pk_bf16(s[2 * 33], s[3 * 33]); o.z = cvt_pk_bf16(s[4 * 33], s[5 * 33]); o.w = cvt_pk_bf16(s[6 * 33], s[7 * 33]);
        *(GAS u32x4*)((GAS bf16_t*)WT + (size_t)(drow0 + n) * ldt + dk0 + 8 * c) = o; }
    asm volatile("s_waitcnt lgkmcnt(0)" ::: "memory");
}

__device__ __forceinline__ void prep_dft(const Params& P, LAS unsigned char* lds, int bid, int G) {
    int tid = threadIdx.x; asm volatile("" : "+v"(tid));
    unsigned char* ws = P.ws;
    LAS unsigned short* tabc = (LAS unsigned short*)(lds + 131072);
    LAS unsigned short* tabs = tabc + 4096;
    for (int i = tid; i < 4096; i += 512) { float s, c; sincospif((float)i * (1.0f / 2048.0f), &s, &c); tabc[i] = (unsigned short)f2bf(c); tabs[i] = (unsigned short)f2bf(s); }
    __syncthreads();
    { bf16_t* DFTM = (bf16_t*)(ws + OFF_DFTM);
      for (int rr = bid; rr < 4096; rr += G) { const int r = ((rr >> 11) << 12) + (rr & 2047); const int k = r & 4095;   const LAS unsigned short* tb = (r >> 12) ? tabs : tabc; const int n0 = tid * 8; unsigned e[8];
#pragma unroll
          for (int j = 0; j < 8; ++j) e[j] = tb[(k * (n0 + j)) & 4095];
          u32x4 o; o.x = e[0] | (e[1] << 16); o.y = e[2] | (e[3] << 16); o.z = e[4] | (e[5] << 16); o.w = e[6] | (e[7] << 16);
          *(GAS u32x4*)((GAS bf16_t*)DFTM + (size_t)r * 4096 + n0) = o; }
      bf16_t* DFTMC = (bf16_t*)(ws + OFF_DFTMC);
      for (int it = bid; it < 32; it += G) { const int r = it * 16 + (tid >> 5), n0 = (tid & 31) * 8, k = r & 255; const LAS unsigned short* tb = (r >> 8) ? tabs : tabc; unsigned e[8];
#pragma unroll
          for (int j = 0; j < 8; ++j) e[j] = tb[((k * (n0 + j)) & 255) << 4];
          u32x4 o; o.x = e[0] | (e[1] << 16); o.y = e[2] | (e[3] << 16); o.z = e[4] | (e[5] << 16); o.w = e[6] | (e[7] << 16);
          *(GAS u32x4*)((GAS bf16_t*)DFTMC + (size_t)r * 256 + n0) = o; } }
    __syncthreads();
}
__device__ __forceinline__ void prep_weights(const Params& P, LAS unsigned char* lds, int lay, int bid, int G, int sel) {
    int tid = threadIdx.x; asm volatile("" : "+v"(tid)); const int lane = tid & 63, wave = tid >> 6;
    unsigned char* ws = P.ws;
    LAS float* tab64 = (LAS float*)(lds + 131072 + 16384);
    if (tid < 64) tab64[tid] = cospif((float)tid * (1.0f / 32.0f));
    __syncthreads();
    { LAS float* scr = (LAS float*)(lds + wave * 16384);
      const int gw = bid * 8 + wave, NGW = G * 8;
      constexpr int I_GU = 16 * 176, I_DN = 44 * 32, I_IN = 16 * 56, I_OUT = 12 * 32;
      constexpr int NIT = 2 * I_GU + 2 * I_DN + I_IN + I_OUT;
      for (int it = gw; it < NIT; it += NGW) { int r = it;
          if (r < 2 * I_GU) { if (!((sel >> (r / I_GU)) & 1)) continue; const int mat = lay * 2 + r / I_GU, ii = r % I_GU, kb = ii / 176, nb = ii % 176, n0 = nb * 32;
              const int drow = n0 < DFF ? (n0 >> 7) * 256 + (n0 & 127) : ((n0 - DFF) >> 7) * 256 + 128 + ((n0 - DFF) & 127);
              transpose_item(P.w_gu + (size_t)mat * 1024 * 5632, 5632, kb * 64, n0, (bf16_t*)(ws + OFF_WGU + mat * SZ_WGU1), 1024, drow, kb * 64, scr, lane); continue; }
          r -= 2 * I_GU;
          if (r < 2 * I_DN) { if (!((sel >> (2 + r / I_DN)) & 1)) continue; const int mat = lay * 2 + r / I_DN, ii = r % I_DN, kb = ii / 32, nb = ii % 32;
              transpose_item(P.w_down + (size_t)mat * DFF * 1024, 1024, kb * 64, nb * 32, (bf16_t*)(ws + OFF_WDN + mat * SZ_WDN1), DFF, nb * 32, kb * 64, scr, lane); continue; }
          r -= 2 * I_DN;
          if (r < I_IN) { if (!(sel & 16)) continue; const int mat = lay, kb = r / 56, nb = r % 56;
              transpose_item(P.w_in + (size_t)mat * 1024 * 1792, 1792, kb * 64, nb * 32, (bf16_t*)(ws + OFF_WIN + mat * SZ_WIN1), 1024, nb * 32, kb * 64, scr, lane); continue; }
          r -= I_IN;
          if (sel & 32) { const int mat = lay, kb = r / 32, nb = r % 32;
              transpose_item(P.w_out + (size_t)mat * 1024 * 1024, 1024, kb * 64, nb * 32, (bf16_t*)(ws + OFF_WOUT + mat * SZ_WOUT1), 1280, nb * 32, kb * 64, scr, lane); } } }
    { const int gt = bid * 512 + tid, NGT = G * 512; const int l = lay;
      for (int idx = gt; idx < ((sel & 32) ? 256 * 1024 : 0); idx += NGT) { const int n = idx & 1023, gj = (idx >> 10) & 255, g = gj >> 6, j = gj & 63;
          const float* wp = P.w_out + (size_t)l * 1024 * 1024 + (size_t)(768 + g * 64) * 1024 + n; float cs = 0.f, sn = 0.f;
#pragma unroll 1
          for (int m0 = 0; m0 < 64; m0 += 32) { float wv[32];
#pragma unroll
              for (int m = 0; m < 32; ++m) wv[m] = wp[(size_t)(m0 + m) * 1024];
#pragma unroll
              for (int m = 0; m < 32; ++m) { const int t = ((m0 + m) * j) & 63; cs += tab64[t] * wv[m]; sn += tab64[(t + 48) & 63] * wv[m]; } }
          bf16_t* o = (bf16_t*)(ws + OFF_WOUT + l * SZ_WOUT1) + (size_t)n * 1280; o[768 + gj] = (bf16_t)f2bf(cs); o[1024 + gj] = (bf16_t)f2bf(-sn); }
      for (int i0 = gt; i0 < ((sel & 64) ? 131072 : 0); i0 += NGT) { const int idx = l * 131072 + i0; const int i = idx & 63, j = (idx >> 6) & 63, hi = idx >> 12;
          ((bf16_t*)(ws + OFF_WGT))[idx] = (bf16_t)f2bf(P.lru_wg[(size_t)hi * 4096 + i * 64 + j]); }
      for (int i0 = gt; i0 < ((sel & 64) ? 65536 : 0); i0 += NGT) { const int idx = l * 65536 + i0; ((bf16_t*)(ws + OFF_GWS))[idx] = (bf16_t)f2bf(P.gmlp_ws[idx]); } }
    __syncthreads();
}
__device__ __forceinline__ void phase_prep(const Params& P, LAS unsigned char* lds) {
    int tid = threadIdx.x; asm volatile("" : "+v"(tid)); const int lane = tid & 63, wave = tid >> 6, G = gridDim.x, bid = blockIdx.x;
    unsigned char* ws = P.ws;
    prep_weights(P, lds, 0, bid, G, 1 | 4);
    { const int gt = bid * 512 + tid, NGT = G * 512;
      for (int idx = gt; idx < 2048; idx += NGT) ((float*)(ws + OFF_SP8))[idx] = 8.0f * log1pf(expf(-P.lru_lam[idx])); }
    __syncthreads();
    { LAS float* sc = (LAS float*)lds;
      LAS float* red = (LAS float*)(lds + 36864);
      for (int i = tid; i < 9 * 1024; i += 512) { const int v = i >> 10, k = i & 1023; const float cv = v < 8 ? P.c[v * 1024 + k] : P.c_ctx[k]; sc[i] = cv / (1.0f + expf(-cv)); }
      __syncthreads();
      float* MOD = (float*)(ws + OFF_MOD);
      for (int it = bid; it < 288; it += G) { const int l = it / 144, col0 = (it % 144) * 64, kc = tid >> 4, cq = tid & 15;
          f32x4 a[9];
#pragma unroll
          for (int v = 0; v < 9; ++v) a[v] = (f32x4){0.f, 0.f, 0.f, 0.f};
          const float* wp = P.w_mod + (size_t)l * 1024 * 9216 + (size_t)(kc * 32) * 9216 + col0 + 4 * cq;
#pragma unroll 1
          for (int k0 = 0; k0 < 32; k0 += 16) { f32x4 wv[16];
#pragma unroll
              for (int k = 0; k < 16; ++k) wv[k] = *(const f32x4*)(wp + (size_t)(k0 + k) * 9216);
#pragma unroll
              for (int k = 0; k < 16; ++k) {
#pragma unroll
                  for (int v = 0; v < 9; ++v) a[v] += wv[k] * sc[v * 1024 + kc * 32 + k0 + k]; } }
#pragma unroll
          for (int v = 0; v < 9; ++v) *(LAS f32x4*)(red + (kc * 9 + v) * 64 + 4 * cq) = a[v];
          __syncthreads();
          for (int o = tid; o < 9 * 64; o += 512) { const int v = o >> 6, cc = o & 63; float s = P.b_mod[l * 9216 + col0 + cc];
#pragma unroll
              for (int q = 0; q < 32; ++q) s += red[(q * 9 + v) * 64 + cc];
              MOD[(size_t)(l * 9 + v) * 9216 + col0 + cc] = s; }
          __syncthreads(); } }
}

__device__ __forceinline__ void norm_store(const f32x4 (&v)[4], const float* modv, int shift_k, int scale_k, const float* g, bf16_t* xnrow, int lane) {
    float ss = 0.f;
#pragma unroll
    for (int j = 0; j < 4; ++j) ss += (v[j].x * v[j].x + v[j].y * v[j].y) + (v[j].z * v[j].z + v[j].w * v[j].w);
    const float rstd = 1.0f / sqrtf(wave_sum(ss) * (1.0f / 1024.0f) + 1e-6f);
#pragma unroll
    for (int j = 0; j < 4; ++j) { const int c0 = 4 * lane + 256 * j;
        const f32x4 gg = *(const f32x4*)(g + c0), sc = *(const f32x4*)(modv + scale_k * 1024 + c0), sh = *(const f32x4*)(modv + shift_k * 1024 + c0);
        const f32x4 y = v[j] * rstd * gg * (sc + 1.0f) + sh;
        u32x2 w; w.x = cvt_pk_bf16(y.x, y.y); w.y = cvt_pk_bf16(y.z, y.w); *(GAS u32x2*)((GAS bf16_t*)xnrow + c0) = w; }
}
__device__ __forceinline__ void phase_init(const Params& P) {
    int tid = threadIdx.x; asm volatile("" : "+v"(tid)); const int lane = tid & 63, wave = tid >> 6, gw = blockIdx.x * 8 + wave, NGW = gridDim.x * 8;
    float* Hc = (float*)(P.ws + OFF_HC); bf16_t* XN = (bf16_t*)(P.ws + OFF_XN); const float* MOD = (const float*)(P.ws + OFF_MOD);
    float fr4[4];
#pragma unroll
    for (int e = 0; e < 4; ++e) fr4[e] = 1.0f / powf(10000.0f, (float)(4 * lane + e) * (1.0f / 256.0f));
    const int sA = gw & 4095, sB = (gw + NGW) & 4095; f32x4 posA[4], posB[4];
#pragma unroll
    for (int e = 0; e < 4; ++e) { float s1, c1, s2, c2;
        sincosf((float)(sA >> 6) * fr4[e], &s1, &c1); sincosf((float)(sA & 63) * fr4[e], &s2, &c2); posA[0][e] = s1; posA[1][e] = c1; posA[2][e] = s2; posA[3][e] = c2;
        sincosf((float)(sB >> 6) * fr4[e], &s1, &c1); sincosf((float)(sB & 63) * fr4[e], &s2, &c2); posB[0][e] = s1; posB[1][e] = c1; posB[2][e] = s2; posB[3][e] = c2; }
#define IN_LOAD(R, V, SC, SH) do { const int _r = (R); const float* _xr = _r < TL ? P.x + (size_t)_r * 1024 : P.ctx + (size_t)(_r - TL) * 1024; const float* _mv = MOD + (size_t)(_r < TL ? (_r >> 12) : 8) * 9216; \
        _Pragma("unroll") for (int j = 0; j < 4; ++j) { const int c0 = 4 * lane + 256 * j; V[j] = *(const f32x4*)(_xr + c0); SC[j] = *(const f32x4*)(_mv + 1024 + c0); SH[j] = *(const f32x4*)(_mv + c0); } } while (0)
    f32x4 gg[4], v[4], sc[4], sh[4];
#pragma unroll
    for (int j = 0; j < 4; ++j) gg[j] = *(const f32x4*)(P.norm_g + 4 * lane + 256 * j);
    if (gw < T) IN_LOAD(gw, v, sc, sh);
    for (int r = gw; r < T; r += NGW) { const int rn = r + NGW; f32x4 vn[4], scn[4], shn[4];
        if (rn < T) IN_LOAD(rn, vn, scn, shn);
        __builtin_amdgcn_sched_barrier(0);
        float* hr;
        if (r < TL) { const int s = r & 4095;
            if (s == sA) {
#pragma unroll
                for (int j = 0; j < 4; ++j) v[j] += posA[j];
            } else if (s == sB) {
#pragma unroll
                for (int j = 0; j < 4; ++j) v[j] += posB[j];
            } else { const float rr = (float)(s >> 6), cc = (float)(s & 63);
#pragma unroll
                for (int e = 0; e < 4; ++e) { float s1, c1, s2, c2; sincosf(rr * fr4[e], &s1, &c1); sincosf(cc * fr4[e], &s2, &c2); v[0][e] += s1; v[1][e] += c1; v[2][e] += s2; v[3][e] += c2; }
            }
            hr = P.out + (size_t)r * 1024; }
        else hr = Hc + (size_t)(r - TL) * 1024;
        float ss = 0.f;
#pragma unroll
        for (int j = 0; j < 4; ++j) { *(f32x4*)(hr + 4 * lane + 256 * j) = v[j]; ss += (v[j].x * v[j].x + v[j].y * v[j].y) + (v[j].z * v[j].z + v[j].w * v[j].w); }
        const float rstd = 1.0f / sqrtf(wave_sum(ss) * (1.0f / 1024.0f) + 1e-6f);
#pragma unroll
        for (int j = 0; j < 4; ++j) { const f32x4 y = v[j] * rstd * gg[j] * (sc[j] + 1.0f) + sh[j];
            u32x2 w; w.x = cvt_pk_bf16(y.x, y.y); w.y = cvt_pk_bf16(y.z, y.w); *(GAS u32x2*)((GAS bf16_t*)XN + (size_t)r * 1024 + 4 * lane + 256 * j) = w; }
        if (rn < T) {
#pragma unroll
            for (int j = 0; j < 4; ++j) { v[j] = vn[j]; sc[j] = scn[j]; sh[j] = shn[j]; } }
    }
#undef IN_LOAD
}
#define NR_LOAD(R, V, SC, SH) do { const int _r = (R); const float* _hr = _r < TL ? P.out + (size_t)_r * 1024 : Hc + (size_t)(_r - TL) * 1024; const float* _mv = MOD + (size_t)(_r < TL ? (_r >> 12) : 8) * 9216; \
        _Pragma("unroll") for (int j = 0; j < 4; ++j) { const int c0 = 4 * lane + 256 * j; V[j] = *(const f32x4*)(_hr + c0); SC[j] = *(const f32x4*)(_mv + (3 * sub + 1) * 1024 + c0); SH[j] = *(const f32x4*)(_mv + (3 * sub) * 1024 + c0); } \
        if (addpart && _r >= TL) { const size_t _o = (size_t)(_r - TL) * 1024; const float* _pr = (const float*)(P.ws + OFF_PART) + _o; _Pragma("unroll") for (int j = 0; j < 4; ++j) V[j] += *(const f32x4*)(_pr + 4 * lane + 256 * j); \
            if (addpart > 1) { const float* _p2 = (const float*)(P.ws + OFF_PART2) + _o; const float* _p3 = (const float*)(P.ws + OFF_PART3) + _o; _Pragma("unroll") for (int j = 0; j < 4; ++j) V[j] += *(const f32x4*)(_p2 + 4 * lane + 256 * j) + *(const f32x4*)(_p3 + 4 * lane + 256 * j); } } } while (0)
__device__ __forceinline__ void phase_norm(const Params& P, int l, int sub, int addpart) {
    int tid = threadIdx.x; asm volatile("" : "+v"(tid)); const int lane = tid & 63, wave = tid >> 6; const int rbeg = blockIdx.x * 8 + wave, rstride = gridDim.x * 8, rend = T;
    const float* Hc = (const float*)(P.ws + OFF_HC); bf16_t* XN = (bf16_t*)(P.ws + OFF_XN); const float* MOD = (const float*)(P.ws + OFF_MOD) + (size_t)l * 9 * 9216;
    const float* g = P.norm_g + (l * 3 + sub) * 1024; f32x4 gg[4];
#pragma unroll
    for (int j = 0; j < 4; ++j) gg[j] = *(const f32x4*)(g + 4 * lane + 256 * j);
    f32x4 v[4], sc[4], sh[4];
    if (rbeg < rend) NR_LOAD(rbeg, v, sc, sh);
    for (int r = rbeg; r < rend; r += rstride) { const int rn = r + rstride; f32x4 vn[4], scn[4], shn[4];
        if (rn < rend) NR_LOAD(rn, vn, scn, shn);
        __builtin_amdgcn_sched_barrier(0);
        if (addpart && r >= TL) { float* hw = (float*)(P.ws + OFF_HC) + (size_t)(r - TL) * 1024;
#pragma unroll
            for (int j = 0; j < 4; ++j) *(f32x4*)(hw + 4 * lane + 256 * j) = v[j]; }
        float ss = 0.f;
#pragma unroll
        for (int j = 0; j < 4; ++j) ss += (v[j].x * v[j].x + v[j].y * v[j].y) + (v[j].z * v[j].z + v[j].w * v[j].w);
        const float rstd = 1.0f / sqrtf(wave_sum(ss) * (1.0f / 1024.0f) + 1e-6f);
#pragma unroll
        for (int j = 0; j < 4; ++j) { const f32x4 y = v[j] * rstd * gg[j] * (sc[j] + 1.0f) + sh[j];
            u32x2 w; w.x = cvt_pk_bf16(y.x, y.y); w.y = cvt_pk_bf16(y.z, y.w); *(GAS u32x2*)((GAS bf16_t*)XN + (size_t)r * 1024 + 4 * lane + 256 * j) = w; }
        if (rn < rend) {
#pragma unroll
            for (int j = 0; j < 4; ++j) { v[j] = vn[j]; sc[j] = scn[j]; sh[j] = shn[j]; } }
    }
}
#undef NR_LOAD
__device__ __forceinline__ void phase_final(const Params& P) {
    int tid = threadIdx.x; asm volatile("" : "+v"(tid)); const int lane = tid & 63, wave = tid >> 6, gw = blockIdx.x * 8 + wave, NGW = gridDim.x * 8;
    f32x4 gg[4], v[4];
#pragma unroll
    for (int j = 0; j < 4; ++j) gg[j] = *(const f32x4*)(P.final_g + 4 * lane + 256 * j);
    if (gw < TL) {
#pragma unroll
        for (int j = 0; j < 4; ++j) v[j] = *(const f32x4*)(P.out + (size_t)gw * 1024 + 4 * lane + 256 * j); }
    for (int r = gw; r < TL; r += NGW) { float* hr = P.out + (size_t)r * 1024; const int rn = r + NGW; f32x4 vn[4];
        if (rn < TL) {
#pragma unroll
            for (int j = 0; j < 4; ++j) vn[j] = *(const f32x4*)(P.out + (size_t)rn * 1024 + 4 * lane + 256 * j); }
        __builtin_amdgcn_sched_barrier(0);
        float ss = 0.f;
#pragma unroll
        for (int j = 0; j < 4; ++j) ss += (v[j].x * v[j].x + v[j].y * v[j].y) + (v[j].z * v[j].z + v[j].w * v[j].w);
        const float rstd = 1.0f / sqrtf(wave_sum(ss) * (1.0f / 1024.0f) + 1e-6f);
#pragma unroll
        for (int j = 0; j < 4; ++j) *(f32x4*)(hr + 4 * lane + 256 * j) = v[j] * rstd * gg[j];
        if (rn < TL) {
#pragma unroll
            for (int j = 0; j < 4; ++j) v[j] = vn[j]; } }
}

__device__ __forceinline__ int queue_pull(unsigned* q, int lane) { unsigned nx = 0; if (lane == 0) nx = __hip_atomic_fetch_add(q, 1u, __ATOMIC_RELAXED, __HIP_MEMORY_SCOPE_AGENT); return 256 + (int)__builtin_amdgcn_readfirstlane(nx); }
__device__ __forceinline__ void gmlp_items(const Params& P, int l, int local, unsigned* q) {
    int tid = threadIdx.x; asm volatile("" : "+v"(tid)); const int lane = tid & 63, wslot = tid >> 6, fr = lane & 15, fq = lane >> 4;
    const GAS bf16_t* GWS = (const GAS bf16_t*)(P.ws + OFF_GWS + l * SZ_GWS1); const GAS bf16_t* Z = (const GAS bf16_t*)(P.ws + OFF_Z); GAS bf16_t* Y = (GAS bf16_t*)(P.ws + OFF_Y);
    const int xq = blockIdx.x & 7;
    for (; local < 680; local = queue_pull(q, lane)) { const int it = xq * 136 + (local - 544); const int ch = it >> 2, g = it & 3; const GAS bf16_t* VTb; int ldv;
        if (ch < 256) { const int b = ch >> 5, n0 = (ch & 31) * 128; VTb = (const GAS bf16_t*)(P.ws + OFF_VT) + ((size_t)b * 256 + g * 64) * 4096 + n0; ldv = 4096; }
        else { const int cc = ch - 256, b = cc >> 1, n0 = (cc & 1) * 128; VTb = (const GAS bf16_t*)(P.ws + OFF_VTC) + ((size_t)b * 256 + g * 64) * 256 + n0; ldv = 256; }
        bf16x8 Afv[4][4];
#pragma unroll
        for (int kk = 0; kk < 4; ++kk)
#pragma unroll
            for (int mt = 0; mt < 4; ++mt) Afv[kk][mt] = *(const GAS bf16x8*)(VTb + (size_t)(mt * 16 + fr) * ldv + kk * 32 + 8 * fq);
#pragma unroll 1
        for (int half = 0; half < 2; ++half) {
            bf16x8 Bfv[4][4]; u32x2 uua[4][4]; float bsv[4];
#pragma unroll
            for (int q = 0; q < 4; ++q) { const int p = 16 * (4 * half + q) + fr; const size_t row = (size_t)ch * 128 + p; bsv[q] = P.gmlp_bs[(l * 4 + g) * 128 + p];
#pragma unroll
                for (int kk = 0; kk < 4; ++kk) Bfv[q][kk] = *(const GAS bf16x8*)(GWS + ((size_t)(g * 128 + p)) * 128 + kk * 32 + 8 * fq);
#pragma unroll
                for (int mt = 0; mt < 4; ++mt) uua[q][mt] = *(const GAS u32x2*)(Z + row * ZW + 1024 + g * 64 + mt * 16 + 4 * fq); }
            __builtin_amdgcn_sched_barrier(0);
#pragma unroll
            for (int q = 0; q < 4; ++q) { const int p = 16 * (4 * half + q) + fr; const size_t row = (size_t)ch * 128 + p;
                f32x4 acc[4];
#pragma unroll
                for (int mt = 0; mt < 4; ++mt) acc[mt] = (f32x4){0.f, 0.f, 0.f, 0.f};
#pragma unroll
                for (int kk = 0; kk < 4; ++kk)
#pragma unroll
                    for (int mt = 0; mt < 4; ++mt) acc[mt] = __builtin_amdgcn_mfma_f32_16x16x32_bf16(Afv[kk][mt], Bfv[q][kk], acc[mt], 0, 0, 0);
#pragma unroll
                for (int mt = 0; mt < 4; ++mt) { const int d0 = mt * 16 + 4 * fq; const u32x2 uu = uua[q][mt];
                    const float u0 = __uint_as_float(uu.x << 16), u1 = __uint_as_float(uu.x & 0xffff0000u), u2 = __uint_as_float(uu.y << 16), u3 = __uint_as_float(uu.y & 0xffff0000u);
                    u32x2 o; o.x = cvt_pk_bf16(u0 * (acc[mt][0] + bsv[q]), u1 * (acc[mt][1] + bsv[q])); o.y = cvt_pk_bf16(u2 * (acc[mt][2] + bsv[q]), u3 * (acc[mt][3] + bsv[q]));
                    *(GAS u32x2*)(Y + row * YW + 512 + g * 64 + d0) = o; } }
        }
    }
}

__device__ __forceinline__ void dft_nyquist(const Params& P) {
    int tid = threadIdx.x; asm volatile("" : "+v"(tid)); const int lane = tid & 63;
    const GAS bf16_t* FT = (const GAS bf16_t*)(P.ws + OFF_FT); GAS bf16_t* Y = (GAS bf16_t*)(P.ws + OFF_Y);
    for (int wi = blockIdx.x * 8 + (tid >> 6); wi < NB * 256; wi += gridDim.x * 8) { const int b = wi >> 8, ch = wi & 255; const GAS bf16_t* fp = FT + ((size_t)b * 256 + ch) * 4096; float a = 0.f;
        u32x4 qv[8];
#pragma unroll
        for (int j = 0; j < 8; ++j) qv[j] = *(const GAS u32x4*)(fp + (size_t)(j * 64 + lane) * 8);
        __builtin_amdgcn_sched_barrier(0);
#pragma unroll
        for (int j = 0; j < 8; ++j) {
#pragma unroll
            for (int e = 0; e < 4; ++e) a += __uint_as_float(qv[j][e] << 16) - __uint_as_float(qv[j][e] & 0xffff0000u); }
        a = wave_sum(a);
        if (lane == 0) { GAS bf16_t* yr = Y + (size_t)(b * 4096 + 2048) * YW; yr[768 + ch] = (bf16_t)f2bf(a * (1.0f / 512.0f)); yr[1024 + ch] = (bf16_t)0; } }
}

__device__ __forceinline__ int lru_pass1(const Params& P, int l, LAS unsigned char* lds, unsigned* qw) {
    int tid = threadIdx.x; asm volatile("" : "+v"(tid)); const int lane = tid & 63, fr = lane & 15, fq = lane >> 4;
    const GAS bf16_t* Z = (const GAS bf16_t*)(P.ws + OFF_Z);
    const GAS bf16_t* WGT = (const GAS bf16_t*)(P.ws + OFF_WGT + l * SZ_WGT1); GAS float* AGG = (GAS float*)(P.ws + OFF_AGG); GAS unsigned* AB = (GAS unsigned*)(P.ws + OFF_AB);
    LAS unsigned short* xcS = (LAS unsigned short*)(lds + (tid >> 6) * 9216);
    LAS unsigned short* xaS = (LAS unsigned short*)(lds + 8 * 9216 + (tid >> 6) * 8704);
    const GAS float* SP8 = (const GAS float*)(P.ws + OFF_SP8);
    const int wslot = tid >> 6;
    const int xq = blockIdx.x & 7, jq = blockIdx.x >> 3;
    int local = jq >= 16 ? (jq - 16) * 8 + wslot : 128 + jq * 8 + wslot;
    for (;;) {
        if (local >= 544) break;
        const int wi = xq * 544 + local;
        const int it = wi >> 3, h = wi & 7;
        int b, j, q, Ls, r0seq;
        if (it < 512) { b = it >> 6; j = it & 63; q = 4 + j; Ls = 4096; r0seq = b * 4096; } else { const int t2 = it - 512; b = t2 >> 2; j = t2 & 3; q = j; Ls = 256; r0seq = TL + b * 256; }
        const int n0 = j * 64, r0 = r0seq + n0;
        {
            u32x4 tq[9];
#pragma unroll
            for (int jq = 0; jq < 9; ++jq) { const int qi = lane + 64 * jq, row = min(qi >> 3, 66), ch8 = qi & 7; const int n = n0 - 2 + row, nn = min(max(n, 0), Ls - 1);
                tq[jq] = *(const GAS u32x4*)(Z + (size_t)(r0seq + nn) * ZW + h * 64 + ch8 * 8); }
            __builtin_amdgcn_sched_barrier(0);
#pragma unroll
            for (int jq = 0; jq < 9; ++jq) { const int qi = lane + 64 * jq, row = qi >> 3, ch8 = qi & 7; if (row < 67) *(LAS u32x4*)(xaS + row * 64 + ch8 * 8) = tq[jq]; }
            asm volatile("s_waitcnt lgkmcnt(0)" ::: "memory");
            const int c = h * 64 + lane; const float* cw = P.conv_w + l * 4 * 512 + c; const float w0 = cw[0], w1 = cw[512], w2 = cw[1024], w3 = cw[1536], cb = P.conv_b[l * 512 + c];
            float xv[67];
#pragma unroll
            for (int i = 0; i < 67; ++i) { const int n = n0 - 2 + i; xv[i] = bf2f(xaS[i * 64 + lane]) * ((n >= 0 && n < Ls) ? 1.0f : 0.0f); }
#pragma unroll
            for (int p = 0; p < 64; ++p) { const float xc = cb + w0 * xv[p] + w1 * xv[p + 1] + w2 * xv[p + 2] + w3 * xv[p + 3]; xcS[p * 72 + lane] = (unsigned short)f2bf(xc); }
        }
        asm volatile("s_waitcnt lgkmcnt(0)" ::: "memory");
        bf16x8 Af[4][2];
#pragma unroll
        for (int mt = 0; mt < 4; ++mt)
#pragma unroll
            for (int kk = 0; kk < 2; ++kk) { const int row = 16 * (fr >> 2) + 4 * mt + (fr & 3); Af[mt][kk] = *(const LAS bf16x8*)(xcS + row * 72 + kk * 32 + 8 * fq); }
#pragma unroll 1
        for (int jt = 0; jt < 4; ++jt) { const int cl = 16 * jt + fr, c = h * 64 + cl;
            f32x4 acc[4][4];
#pragma unroll
            for (int mt = 0; mt < 4; ++mt)
#pragma unroll
                for (int dt = 0; dt < 4; ++dt) acc[mt][dt] = (f32x4){0.f, 0.f, 0.f, 0.f};
            bf16x8 Bfr[4][2];
#pragma unroll
            for (int dt = 0; dt < 4; ++dt)
#pragma unroll
                for (int kk = 0; kk < 2; ++kk) Bfr[dt][kk] = *(const GAS bf16x8*)(WGT + ((size_t)((dt * 8 + h) * 64 + cl)) * 64 + kk * 32 + 8 * fq);
            __builtin_amdgcn_sched_barrier(0);
#pragma unroll
            for (int dt = 0; dt < 4; ++dt)
#pragma unroll
                for (int kk = 0; kk < 2; ++kk) {
#pragma unroll
                    for (int mt = 0; mt < 4; ++mt) acc[mt][dt] = __builtin_amdgcn_mfma_f32_16x16x32_bf16(Af[mt][kk], Bfr[dt][kk], acc[mt][dt], 0, 0, 0); }
            u32x2 abw[16];
#pragma unroll
            for (int d = 0; d < 2; ++d) {
                const float bgr = P.lru_bg[((l * 2 + d) * 2 + 0) * 512 + c], bgi = P.lru_bg[((l * 2 + d) * 2 + 1) * 512 + c];
                const float sp8 = SP8[(l * 2 + d) * 512 + c];
#pragma unroll
                for (int mt = 0; mt < 4; ++mt)
#pragma unroll
                    for (int ip = 0; ip < 2; ++ip) { const int p = 16 * fq + 4 * mt + 2 * ip;
                        const f32x2 xcv = (f32x2){bf2f(xcS[p * 72 + cl]), bf2f(xcS[(p + 1) * 72 + cl])};
                        const f32x2 tr = ((f32x2){acc[mt][2 * d][2 * ip], acc[mt][2 * d][2 * ip + 1]} + bgr) * (-1.4426950408889634f);
                        const f32x2 ti = ((f32x2){acc[mt][2 * d + 1][2 * ip], acc[mt][2 * d + 1][2 * ip + 1]} + bgi) * (-1.4426950408889634f);
                        const f32x2 dr = (f32x2){__builtin_amdgcn_exp2f(tr.x), __builtin_amdgcn_exp2f(tr.y)} + 1.0f, di = (f32x2){__builtin_amdgcn_exp2f(ti.x), __builtin_amdgcn_exp2f(ti.y)} + 1.0f;
                        const f32x2 r = (f32x2){__builtin_amdgcn_rcpf(dr.x), __builtin_amdgcn_rcpf(dr.y)}, ig = (f32x2){__builtin_amdgcn_rcpf(di.x), __builtin_amdgcn_rcpf(di.y)};
                        const f32x2 la = r * (-sp8), x2 = la + la;
                        f32x2 q5 = x2 * 0.0083333333f + 0.041666668f; q5 = q5 * x2 + 0.16666667f; q5 = q5 * x2 + 0.5f; q5 = q5 * x2 + 1.0f; f32x2 em = -(x2 * q5);
                        if (__builtin_expect(__any((x2.x < -0.25f) || (x2.y < -0.25f)), 0)) {
                            if (x2.x < -0.25f) em.x = 1.0f - __expf(x2.x);
                            if (x2.y < -0.25f) em.y = 1.0f - __expf(x2.y); }
                        const f32x2 tl = la * 1.4426950408889634f; const f32x2 om = 1.0f - (f32x2){__builtin_amdgcn_exp2f(tl.x), __builtin_amdgcn_exp2f(tl.y)};
                        const f32x2 bvv = (f32x2){__builtin_amdgcn_sqrtf(em.x), __builtin_amdgcn_sqrtf(em.y)} * ig * xcv;
                        const unsigned wq0 = cvt_pk_bf16(om.x, bvv.x), wq1 = cvt_pk_bf16(om.y, bvv.y);
                        acc[mt][2 * d][2 * ip] = 1.0f - __uint_as_float(wq0 << 16); acc[mt][2 * d + 1][2 * ip] = __uint_as_float(wq0 & 0xffff0000u);
                        acc[mt][2 * d][2 * ip + 1] = 1.0f - __uint_as_float(wq1 << 16); acc[mt][2 * d + 1][2 * ip + 1] = __uint_as_float(wq1 & 0xffff0000u);
                        abw[mt * 4 + 2 * ip][d] = wq0; abw[mt * 4 + 2 * ip + 1][d] = wq1; }
                float Ar = 1.f, Br = 0.f;
#pragma unroll
                for (int s = 0; s < 16; ++s) { const int idx = d == 0 ? s : 15 - s; const float a = acc[idx >> 2][2 * d][idx & 3], bb = acc[idx >> 2][2 * d + 1][idx & 3]; Br = a * Br + bb; Ar *= a; }
                float Ac = 1.f, Bc = 0.f;
#pragma unroll
                for (int s = 0; s < 4; ++s) { const int f = d == 0 ? s : 3 - s; const float af = __shfl(Ar, fr + 16 * f), bf = __shfl(Br, fr + 16 * f); Bc = af * Bc + bf; Ac *= af; }
                if (fq == 0) { GAS float* ap = AGG + ((size_t)((b * NQ + q) * 2 + d) * 2) * 512 + c; ap[0] = Ac; ap[512] = Bc; }
            }
#pragma unroll
            for (int idx = 0; idx < 16; ++idx) *(GAS u32x2*)(AB + ((size_t)(r0 + 16 * fq + idx) * 512 + c) * 2) = abw[idx];
        }
        asm volatile("s_waitcnt lgkmcnt(0)" ::: "memory");
        local = queue_pull(qw, lane);
    }
    return local;
}
__device__ __forceinline__ void lru_scan(const Params& P, int l) {
    int tid = threadIdx.x; asm volatile("" : "+v"(tid)); const int c = tid;
    const GAS bf16_t* Z = (const GAS bf16_t*)(P.ws + OFF_Z); GAS bf16_t* Y = (GAS bf16_t*)(P.ws + OFF_Y);
    const GAS float* AGG = (const GAS float*)(P.ws + OFF_AGG); const GAS unsigned* AB = (const GAS unsigned*)(P.ws + OFF_AB);
    const int nitems = (l == 1) ? 512 : 544;
    for (int it = blockIdx.x; it < nitems; it += gridDim.x) {
        int b, j, q, r0seq;
        if (it < 512) { b = it >> 6; j = it & 63; q = 4 + j; r0seq = b * 4096; } else { const int t2 = it - 512; b = t2 >> 2; j = t2 & 3; q = j; r0seq = TL + b * 256; }
        const int r0 = r0seq + j * 64;
        float hin[2];
#pragma unroll
        for (int d = 0; d < 2; ++d) { const int rank = d == 0 ? q : (q < 4 ? 3 - q : 71 - q); float hh = 0.f;
#pragma unroll 1
            for (int r8 = 0; r8 < rank; r8 += 34) { float aa[34], bv[34];
#pragma unroll
                for (int k = 0; k < 34; ++k) { const int rho = r8 + k; const bool ok = rho < rank; const int rr = ok ? rho : 0; const int qq = d == 0 ? rr : (rr < 4 ? 3 - rr : 71 - rr);
                    const GAS float* ap = AGG + ((size_t)((b * NQ + qq) * 2 + d) * 2) * 512 + c; const float a0 = ap[0], b0 = ap[512]; aa[k] = ok ? a0 : 1.f; bv[k] = ok ? b0 : 0.f; }
#pragma unroll
                for (int k = 0; k < 34; ++k) hh = aa[k] * hh + bv[k]; }
            hin[d] = hh; }
        const GAS u32x2* abp = (const GAS u32x2*)(AB + ((size_t)r0 * 512 + c) * 2);
        u32x2 w[64];
#pragma unroll
        for (int p = 0; p < 64; ++p) w[p] = abp[(size_t)p * 512];
        float hf[64]; { float hh = hin[0];
#pragma unroll
            for (int p = 0; p < 64; ++p) { const float om = __uint_as_float(w[p].x << 16), bb = __uint_as_float(w[p].x & 0xffff0000u); hh = (hh - om * hh) + bb; hf[p] = hh; } }
        unsigned short gar[64];
#pragma unroll
        for (int p = 0; p < 64; ++p) gar[p] = Z[(size_t)(r0 + p) * ZW + 512 + c];
        { float hh = hin[1];
#pragma unroll
            for (int p = 63; p >= 0; --p) { const float om = __uint_as_float(w[p].y << 16), bb = __uint_as_float(w[p].y & 0xffff0000u); hh = (hh - om * hh) + bb;
                Y[(size_t)(r0 + p) * YW + c] = (bf16_t)f2bf((hf[p] + hh) * bf2f(gar[p])); } }
    }
}

#define XB_TMO      128
#define XB_XCNT(j)  (256  + 64 * (j))
#define XB_XSUB(j)  (1280 + 64 * (j))
#define XB_XGEN(j)  (2304 + 64 * (j))
#define XB_TOP      3328
#define XB_TOPGEN   3392
#define XCD_BAR_WORDS 3456
#define XB_SPIN_CAP (1u << 22)
__device__ __forceinline__ unsigned xb_ld(unsigned* p)              { return __hip_atomic_load(p, __ATOMIC_RELAXED, __HIP_MEMORY_SCOPE_AGENT); }
__device__ __forceinline__ unsigned xb_add(unsigned* p, unsigned v) { return __hip_atomic_fetch_add(p, v, __ATOMIC_RELAXED, __HIP_MEMORY_SCOPE_AGENT); }
__device__ __forceinline__ unsigned xb_xcc_id() { return (unsigned)__builtin_amdgcn_s_getreg((3 << 11) | 20) & 0xFu; }
#define XB_SPIN(cond, bar) do { unsigned _sp = 0; while (cond) { __builtin_amdgcn_s_sleep(1); \
    if ((++_sp & 255u) == 0u) { if (xb_ld(&(bar)[XB_TMO])) break; if (_sp > XB_SPIN_CAP) { atomicAdd(&(bar)[XB_TMO], 1u); break; } } } } while (0)
struct XcdBarrier { unsigned* bar; unsigned x; volatile LAS unsigned* st; };
__device__ __forceinline__ XcdBarrier xcd_barrier_post(unsigned* bar, volatile LAS unsigned* st) {
    XcdBarrier b; b.bar = bar; b.x = xb_xcc_id(); b.st = st;
    if (threadIdx.x == 0) (void)xb_add(&bar[XB_XCNT(b.x)], 1u);
    return b;
}
__device__ __forceinline__ void xcd_barrier_complete(unsigned* bar, unsigned x, unsigned& nloc, unsigned& nx) {
    const unsigned G = gridDim.x * gridDim.y * gridDim.z;
    unsigned sum, cnt, mine, sp = 0u;
    for (;;) {
        sum = 0u; cnt = 0u; mine = 0u;
#pragma unroll
        for (unsigned j = 0; j < 16; ++j) { const unsigned c = xb_ld(&bar[XB_XCNT(j)]); sum += c; cnt += (c > 0u) ? 1u : 0u; mine = (j == x) ? c : mine; }
        if (sum == G) break;
        __builtin_amdgcn_s_sleep(1);
        if ((++sp & 255u) == 0u) { if (xb_ld(&bar[XB_TMO])) break; if (sp > XB_SPIN_CAP) { atomicAdd(&bar[XB_TMO], 1u); break; } }
    }
    nloc = mine > 0u ? mine : 1u; nx = cnt > 0u ? cnt : 1u;
}
__device__ __forceinline__ void xcd_barrier(const XcdBarrier& b) {
    asm volatile("s_waitcnt vmcnt(0)" ::: "memory");
    __syncthreads();
    if (threadIdx.x == 0) {
        unsigned* bar = b.bar;
        __builtin_amdgcn_s_waitcnt(0);
        unsigned nloc = b.st[0], nx = b.st[1];
        if (nloc == 0u) { xcd_barrier_complete(bar, b.x, nloc, nx); b.st[0] = nloc; b.st[1] = nx; }
        const unsigned old = xb_add(&bar[XB_XSUB(b.x)], 1u);
        const unsigned gen = old / nloc;
        if (old + 1u == (gen + 1u) * nloc) {
            __builtin_amdgcn_fence(__ATOMIC_RELEASE, "agent");
            asm volatile("s_waitcnt vmcnt(0)" ::: "memory");
            const unsigned og = xb_add(&bar[XB_TOP], 1u);
            const unsigned tg = og / nx;
            if (og + 1u == (tg + 1u) * nx) xb_add(&bar[XB_TOPGEN], 1u);
            else XB_SPIN(xb_ld(&bar[XB_TOPGEN]) == tg, bar);
            __builtin_amdgcn_fence(__ATOMIC_ACQUIRE, "agent");
            xb_add(&bar[XB_XGEN(b.x)], 1u);
            asm volatile("s_waitcnt vmcnt(0)" ::: "memory");
        } else {
            XB_SPIN(xb_ld(&bar[XB_XGEN(b.x)]) == gen, bar);
            __builtin_amdgcn_fence(__ATOMIC_ACQUIRE, "agent");
            asm volatile("s_waitcnt vmcnt(0)" ::: "memory");
        }
    }
    __syncthreads();
}

__global__ void __launch_bounds__(512, 2) mega(Params P) {
    extern __shared__ __attribute__((aligned(16))) unsigned char lds_raw[];
    LAS unsigned char* lds = (LAS unsigned char*)lds_raw;
    cg::grid_group grid = cg::this_grid();
    unsigned char* ws = P.ws; const int G = gridDim.x, c = blockIdx.x;
    if (P.ph_lo < 0) grid.sync();
    volatile LAS unsigned* MISC = (volatile LAS unsigned*)(lds + 148480);
    if (threadIdx.x < 2) MISC[threadIdx.x] = 0u;
    __syncthreads();
    const XcdBarrier bar = xcd_barrier_post((unsigned*)(ws + OFF_BAR), MISC);
    int ph = 0;
#define RUN(...) do { if (ph >= P.ph_lo && ph < P.ph_hi) { __VA_ARGS__; if (ph + 1 < P.ph_hi) xcd_barrier(bar); } ++ph; } while (0)
    RUN(phase_prep(P, lds));
    RUN(phase_init(P));
    float* Hc = (float*)(ws + OFF_HC);
    for (int l = 0; l < 2; ++l) {
        const float* MODl = (const float*)(ws + OFF_MOD) + (size_t)l * 9 * 9216;
        for (int f = 0; f < 2; ++f) {
            if (f == 1) {
                RUN(phase_norm(P, l, 1, l == 1 ? 3 : 1));
                RUN({ InOrder S{(const char*)(ws + OFF_XN), (const char*)(ws + OFF_WIN + l * SZ_WIN1), G, c};
                      EpiIn E{(bf16_t*)(ws + OFF_Z), (bf16_t*)(ws + OFF_VT), (bf16_t*)(ws + OFF_VTC), (bf16_t*)(ws + OFF_FT), (bf16_t*)(ws + OFF_FTC)};
                      gemm_phase(lds, 1024, S, E); });
                RUN({ { DftOrder S{(const char*)(ws + OFF_DFTM), (const char*)(ws + OFF_FT), G, c}; EpiDft E{(bf16_t*)(ws + OFF_Y)}; gemm_phase(lds, 4096, S, E); }
                      if (l == 0) { DftCOrder S{(const char*)(ws + OFF_DFTMC), (const char*)(ws + OFF_FTC), G, c}; EpiDft E{(bf16_t*)(ws + OFF_Y)}; gemm_phase(lds, 256, S, E); }
                      __syncthreads();
                      dft_nyquist(P);
                      { unsigned* q = (unsigned*)(ws + OFF_BAR) + XCD_BAR_WORDS + 16 * (8 * l + (c & 7));
                        const int lg = lru_pass1(P, l, lds, q); gmlp_items(P, l, lg, q); } });
                RUN(lru_scan(P, l));
                RUN({ SplitOrder S{(const char*)(ws + OFF_Y), (const char*)(ws + OFF_WOUT + l * SZ_WOUT1), l == 1 ? 0 : 2, G, c, (size_t)256 * 1280 * 2, 20};
                      EpiRes E{P.out, Hc, MODl + 5 * 1024, (float*)(ws + OFF_PART), 1.0f, 0}; gemm_phase(lds, 1280, S, E); });
                RUN(phase_norm(P, l, 2, l == 0 ? 3 : 0));
            }
            RUN({ StaticOrder S{(const char*)(ws + OFF_XN), (const char*)(ws + OFF_WGU + (l * 2 + f) * SZ_WGU1), (l == 1 && f == 1) ? 128 : NPAN, 22, G, c, (size_t)256 * 1024 * 2, 16};
                  EpiGU E{(bf16_t*)(ws + OFF_ACT)}; gemm_phase(lds, 1024, S, E); });
            RUN({ SplitOrder S{(const char*)(ws + OFF_ACT), (const char*)(ws + OFF_WDN + (l * 2 + f) * SZ_WDN1), (l == 1 && f == 1) ? 0 : (l == 1 ? 2 : 1), G, c, (size_t)256 * DFF * 2, 44};
                  EpiRes E{P.out, Hc, MODl + (f == 0 ? 2 : 8) * 1024, (float*)(ws + OFF_PART), 0.5f, 0}; gemm_phase(lds, DFF, S, E);
                  if (l == 0 && c >= 64) { if (f == 0) { prep_dft(P, lds, c - 64, 192); prep_weights(P, lds, 0, c - 64, 192, 0x7f & ~(1 | 4)); } else prep_weights(P, lds, 1, c - 64, 192, 0x7f); } });
        }
        if (l == 0) RUN(phase_norm(P, 1, 0, 1)); else RUN(phase_final(P));
    }
#undef RUN
#ifdef PROBE
    xcd_barrier(bar);
#if PROBE == 1
    for (int i = 0; i < 40; ++i) xcd_barrier(bar);
#elif PROBE == 2
    for (int i = 0; i < 3; ++i) { gmlp_items(P, 1); lru_pass1(P, 1, lds); xcd_barrier(bar); lru_scan(P, 1); xcd_barrier(bar); }
#elif PROBE == 3
    for (int i = 0; i < 2; ++i) { phase_prep(P, lds); xcd_barrier(bar); }
#endif
#endif
}
constexpr int N_PHASES = 2 + 2 * 11;

extern "C" void kernel_launch(void* const* d_in, const int* in_sizes, int n_in, void* d_out, int out_size, void* d_ws, size_t ws_size, hipStream_t stream) {
    static int grid = 0;
    if (grid == 0) {
        if (n_in != 19 || out_size != TL * D || ws_size < WS_END) { fprintf(stderr, "kernel_launch: unexpected shapes (n_in %d out %d ws %zu need %zu)\n", n_in, out_size, ws_size, (size_t)WS_END); grid = -1; return; }
        int dev = 0, cus = 0, per_cu = 0;
        hipGetDevice(&dev); hipDeviceGetAttribute(&cus, hipDeviceAttributeMultiprocessorCount, dev);
        if (hipFuncSetAttribute((const void*)mega, hipFuncAttributeMaxDynamicSharedMemorySize, LDS_BYTES) != hipSuccess) { fprintf(stderr, "kernel_launch: hipFuncSetAttribute failed\n"); grid = -1; return; }
        hipOccupancyMaxActiveBlocksPerMultiprocessor(&per_cu, (const void*)mega, 512, LDS_BYTES);
        (void)hipGetLastError();
        if (per_cu < 1) per_cu = 1;
        grid = cus;
    }
    if (grid < 0) return;
    Params p{};
    p.x = (const float*)d_in[0]; p.c = (const float*)d_in[1]; p.ctx = (const float*)d_in[2]; p.c_ctx = (const float*)d_in[3]; p.w_mod = (const float*)d_in[4]; p.b_mod = (const float*)d_in[5];
    p.norm_g = (const float*)d_in[6]; p.w_gu = (const float*)d_in[7]; p.w_down = (const float*)d_in[8]; p.w_in = (const float*)d_in[9]; p.w_out = (const float*)d_in[10];
    p.conv_w = (const float*)d_in[11]; p.conv_b = (const float*)d_in[12]; p.lru_wg = (const float*)d_in[13]; p.lru_bg = (const float*)d_in[14]; p.lru_lam = (const float*)d_in[15];
    p.gmlp_ws = (const float*)d_in[16]; p.gmlp_bs = (const float*)d_in[17]; p.final_g = (const float*)d_in[18];
    p.out = (float*)d_out; p.ws = (unsigned char*)d_ws; p.ph_lo = 0; p.ph_hi = N_PHASES;
    if (hipMemsetAsync((char*)d_ws + OFF_BAR, 0, 16384, stream) != hipSuccess) { fprintf(stderr, "kernel_launch: hipMemsetAsync failed\n"); return; }
    void* args[] = {&p};
    hipError_t e = hipLaunchCooperativeKernel((const void*)mega, dim3(grid), dim3(512), args, LDS_BYTES, stream);
    if (e != hipSuccess) fprintf(stderr, "kernel_launch: cooperative launch failed: %s (grid %d)\n", hipGetErrorString(e), grid);
}
```
